# Optimizing an MI355X kernel written in HIP

```python
import math
import jax, jax.numpy as jnp
from jax import lax
import numpy as np

D_MODEL = 1024
BATCH = 32
SEQ = 2048
DEPTH = 1

HEAD_DIM = 64
SB_HEADS = (D_MODEL // 2) // HEAD_DIM
DIFF_HEADS = (D_MODEL // 2) // (2 * HEAD_DIM)
SB_WIDTH = SB_HEADS * HEAD_DIM
DIFF_WIDTH = DIFF_HEADS * 2 * HEAD_DIM
MIX_WIDTH = SB_WIDTH + DIFF_WIDTH
IN_WIDTH = 3 * MIX_WIDTH
D_FF = -(-8 * D_MODEL // (3 * 256)) * 256
Q_BLOCK = 128
ROPE_THETA = 10000.0
NORM_EPS = 1e-6
SUBLN_EPS = 1e-5

kernel_name = "hybrid_stickbreak_diffattn_swiglu"


def rmsnorm(x, g, eps=NORM_EPS):
    xf = x.astype(jnp.float32)
    y = xf * lax.rsqrt(jnp.mean(xf * xf, axis=-1, keepdims=True) + eps) * g.astype(jnp.float32)
    return y.astype(x.dtype)


def rope(x, pos):
    half = HEAD_DIM // 2
    inv_freq = ROPE_THETA ** (-jnp.arange(half, dtype=jnp.float32) / half)
    ang = pos.astype(jnp.float32)[:, None] * inv_freq[None, :]
    cos, sin = jnp.cos(ang), jnp.sin(ang)
    xf = x.astype(jnp.float32)
    x1, x2 = xf[..., :half], xf[..., half:]
    return jnp.concatenate([x1 * cos - x2 * sin, x1 * sin + x2 * cos], axis=-1).astype(x.dtype)


def stick_breaking_attention(q, k, v):
    S = q.shape[2]
    scale = HEAD_DIM ** -0.5
    outs = []
    for start in range(0, S, Q_BLOCK):
        end = start + Q_BLOCK
        z = jnp.einsum('bhqd,bhkd->bhqk', q[:, :, start:end], k[:, :, :end]).astype(jnp.float32) * scale
        past = jnp.arange(end)[None, :] < jnp.arange(start, end)[:, None]
        log_beta = jax.nn.log_sigmoid(z)
        log_1m = jnp.where(past, jax.nn.log_sigmoid(-z), 0.0)
        acc = lax.cumsum(log_1m, axis=3, reverse=True) - log_1m
        w = jnp.where(past, jnp.exp(log_beta + acc), 0.0)
        outs.append(jnp.einsum('bhqk,bhkd->bhqd', w.astype(v.dtype), v[:, :, :end]))
    return jnp.concatenate(outs, axis=2)


def differential_attention(q, k, v, lam):
    S = q.shape[3]
    scale = HEAD_DIM ** -0.5
    outs = []
    for start in range(0, S, Q_BLOCK):
        end = start + Q_BLOCK
        s = jnp.einsum('bhcqd,bhckd->bhcqk', q[:, :, :, start:end], k[:, :, :, :end]).astype(jnp.float32) * scale
        causal = jnp.arange(end)[None, :] <= jnp.arange(start, end)[:, None]
        p = jax.nn.softmax(jnp.where(causal, s, -jnp.inf), axis=-1)
        a = p[:, :, 0] - lam * p[:, :, 1]
        outs.append(jnp.einsum('bhqk,bhkd->bhqd', a.astype(v.dtype), v[:, :, :end]))
    return jnp.concatenate(outs, axis=2)


def setup_inputs(seed: int = 0) -> dict:
    key = jax.random.key(seed)
    ks = jax.random.split(key, 16)
    f32 = jnp.float32
    nrm = lambda k, shape, s: jax.random.normal(k, shape, f32) * s
    return {
        "x": nrm(ks[0], (BATCH, SEQ, D_MODEL), 1.0),
        "attn_norm_g": 1.0 + nrm(ks[1], (DEPTH, D_MODEL), 0.02),
        "w_in": nrm(ks[2], (DEPTH, D_MODEL, IN_WIDTH), D_MODEL ** -0.5),
        "diff_q_norm_g": 1.0 + nrm(ks[3], (DEPTH, HEAD_DIM), 0.02),
        "diff_k_norm_g": 1.0 + nrm(ks[4], (DEPTH, HEAD_DIM), 0.02),
        "lambda_q1": nrm(ks[5], (DEPTH, HEAD_DIM), 0.1),
        "lambda_k1": nrm(ks[6], (DEPTH, HEAD_DIM), 0.1),
        "lambda_q2": nrm(ks[7], (DEPTH, HEAD_DIM), 0.1),
        "lambda_k2": nrm(ks[8], (DEPTH, HEAD_DIM), 0.1),
        "diff_subln_g": 1.0 + nrm(ks[9], (DEPTH, 2 * HEAD_DIM), 0.02),
        "w_o": nrm(ks[10], (DEPTH, MIX_WIDTH, D_MODEL), MIX_WIDTH ** -0.5),
        "ffn_norm_g": 1.0 + nrm(ks[11], (DEPTH, D_MODEL), 0.02),
        "w_gate": nrm(ks[12], (DEPTH, D_MODEL, D_FF), D_MODEL ** -0.5),
        "w_up": nrm(ks[13], (DEPTH, D_MODEL, D_FF), D_MODEL ** -0.5),
        "w_down": nrm(ks[14], (DEPTH, D_FF, D_MODEL), D_FF ** -0.5),
    }


def reference(x, attn_norm_g, w_in, diff_q_norm_g, diff_k_norm_g, lambda_q1, lambda_k1,
              lambda_q2, lambda_k2, diff_subln_g, w_o, ffn_norm_g, w_gate, w_up, w_down):
    B, S, _ = x.shape
    pos = jnp.arange(S, dtype=jnp.int32)
    for layer in range(DEPTH):
        lambda_init = 0.8 - 0.6 * math.exp(-0.3 * layer)
        h = rmsnorm(x, attn_norm_g[layer])
        proj = h @ w_in[layer]
        sb_q, sb_k, sb_v, d_q, d_k, d_v = jnp.split(
            proj, [SB_WIDTH, 2 * SB_WIDTH, 3 * SB_WIDTH,
                   3 * SB_WIDTH + DIFF_WIDTH, 3 * SB_WIDTH + 2 * DIFF_WIDTH], axis=-1)

        to_heads = lambda t: t.reshape(B, S, SB_HEADS, HEAD_DIM).transpose(0, 2, 1, 3)
        sb_out = stick_breaking_attention(to_heads(sb_q), to_heads(sb_k), to_heads(sb_v))
        sb_out = sb_out.transpose(0, 2, 1, 3).reshape(B, S, SB_WIDTH)

        to_pair = lambda t: t.reshape(B, S, DIFF_HEADS, 2, HEAD_DIM).transpose(0, 2, 3, 1, 4)
        dq = rope(rmsnorm(to_pair(d_q), diff_q_norm_g[layer]), pos)
        dk = rope(rmsnorm(to_pair(d_k), diff_k_norm_g[layer]), pos)
        dv = d_v.reshape(B, S, DIFF_HEADS, 2 * HEAD_DIM).transpose(0, 2, 1, 3)
        lam = (jnp.exp(jnp.sum(lambda_q1[layer].astype(jnp.float32) * lambda_k1[layer].astype(jnp.float32)))
               - jnp.exp(jnp.sum(lambda_q2[layer].astype(jnp.float32) * lambda_k2[layer].astype(jnp.float32)))
               + lambda_init)
        d_out = differential_attention(dq, dk, dv, lam)
        d_out = rmsnorm(d_out, diff_subln_g[layer], SUBLN_EPS) * (1.0 - lambda_init)
        d_out = d_out.transpose(0, 2, 1, 3).reshape(B, S, DIFF_WIDTH)

        mix = jnp.concatenate([sb_out, d_out.astype(sb_out.dtype)], axis=-1)
        x = x + mix @ w_o[layer]

        h2 = rmsnorm(x, ffn_norm_g[layer])
        x = x + (jax.nn.silu(h2 @ w_gate[layer]) * (h2 @ w_up[layer])) @ w_down[layer]
    return x
```

```cpp
#include <hip/hip_runtime.h>
#include <hip/hip_cooperative_groups.h>
#include <cstdio>
#include <cstdint>
namespace cg = cooperative_groups;
namespace pg8 {
#define PG8_LAS __attribute__((address_space(3)))
typedef unsigned short bf16_t;
typedef short bf16x8 __attribute__((ext_vector_type(8)));
typedef float f32x4 __attribute__((ext_vector_type(4)));
typedef unsigned u32x4 __attribute__((ext_vector_type(4)));
constexpr int BM = 256, BK = 64, HALF = 128, HTB = HALF * BK * 2  , STAGE_BYTES = 8 * HTB, NXCD = 8, WGM = 8;

__host__ __device__ __forceinline__ int lds_byte(int r, int c) { const int st = (r >> 4) * 2 + (c >> 5), rr = r & 15, cc = c & 31, ob = rr * 64 + cc * 2; return st * 1024 + (ob ^ (((ob >> 9) & 1) << 5)); }
__host__ __device__ __forceinline__ void stage_rc(int b, int& R, int& C) { const int st = b / 1024, sb = b % 1024, swz = sb ^ (((sb >> 9) & 1) << 5); R = (st >> 1) * 16 + swz / 64; C = (st & 1) * 32 + (swz % 64) / 2; }
__host__ __device__ __forceinline__ int perm32(int rho) { const int n = rho >> 4, i = rho & 15; return 8 * (i >> 2) + 4 * n + (i & 3); }

struct Unit { int pm, pn; };
struct Gemm { const bf16_t* A; const bf16_t* Bt; int M, N, K; };

struct StaticOrder {
    int nM, nN, nwg, G, c;
    __host__ __device__ void init(int M, int N, int G_, int c_) { nM = M / BM; nN = N / BM; nwg = nM * nN; G = G_; c = c_; }
    __host__ __device__ bool next(int i, Unit& u) const {
        const long L = (long)i * G + c; if (L >= nwg) return false;
        int wgid = (int)L; { const int q = nwg / NXCD, r = nwg % NXCD, xcd = wgid % NXCD, off = wgid / NXCD; wgid = (xcd < r ? xcd * (q + 1) : r * (q + 1) + (xcd - r) * q) + off; }
        const int nig = WGM * nN, gid = wgid / nig, fm = gid * WGM, gsz = (nM - fm) < WGM ? (nM - fm) : WGM;
        u.pm = fm + ((wgid % nig) % gsz); u.pn = (wgid % nig) / gsz; return true;
    }
    __device__ __forceinline__ void a_ready(const Unit&) const {}
    __device__ __forceinline__ void done(const Unit&) const {}
};

typedef float f32x2_cv __attribute__((ext_vector_type(2))); typedef __bf16 bf16x2_cv __attribute__((ext_vector_type(2)));
__device__ __forceinline__ unsigned cvt_pk_bf16(float lo, float hi) { f32x2_cv v = {lo, hi}; bf16x2_cv b = __builtin_convertvector(v, bf16x2_cv); return __builtin_bit_cast(unsigned, b); }
__device__ __forceinline__ u32x4 pack8(const f32x4 a, const f32x4 b) { u32x4 w; w.x = cvt_pk_bf16(a[0], a[1]); w.y = cvt_pk_bf16(a[2], a[3]); w.z = cvt_pk_bf16(b[0], b[1]); w.w = cvt_pk_bf16(b[2], b[3]); return w; }

struct EpiQK {
    static constexpr bool PERM = true, AFTER_DRAIN = false;
    bf16_t* O; const float* rstd; const float* gq; const float* gk; const float* rc; const float* rs;
    __device__ __forceinline__ void operator()(const f32x4 (&acc)[2][2][4][2], const Unit& u, int wr, int wc, int fr, int fq) const {
        const int pn = u.pn; const bool is_diff = pn >= 4;
        const float qscale = (pn < 2) ? 0.125f * 1.4426950408889634f : 1.0f;
        const float* g = (pn >= 6) ? gk : gq;
        const int col0 = pn * 256 + wc * 64 + 8 * fq;
        f32x4 g1a = {1.f, 1.f, 1.f, 1.f}, g1b = g1a, g2a = g1a, g2b = g1a;
        if (is_diff) { g1a = *(const f32x4*)(g + 8 * fq); g1b = *(const f32x4*)(g + 8 * fq + 4); g2a = *(const f32x4*)(g + 32 + 8 * fq); g2b = *(const f32x4*)(g + 32 + 8 * fq + 4); }
        float rs8[8];
#pragma unroll
        for (int it = 0; it < 8; ++it) rs8[it] = rstd[u.pm * BM + (it >> 2) * HALF + wr * 64 + (it & 3) * 16 + fr];
        f32x4 cs[4];
#define QK_LOAD(IT) { const int pos_ = (u.pm * BM + ((IT) >> 2) * HALF + wr * 64 + ((IT) & 3) * 16 + fr) & 2047; \
            cs[0] = *(const f32x4*)(rc + pos_ * 32 + 8 * fq); cs[1] = *(const f32x4*)(rc + pos_ * 32 + 8 * fq + 4); cs[2] = *(const f32x4*)(rs + pos_ * 32 + 8 * fq); cs[3] = *(const f32x4*)(rs + pos_ * 32 + 8 * fq + 4); }
        if (is_diff) QK_LOAD(0);
#pragma unroll
        for (int ai = 0; ai < 2; ++ai)
#pragma unroll
            for (int m = 0; m < 4; ++m) {
                const int row = u.pm * BM + ai * HALF + wr * 64 + m * 16 + fr;
                const float rsd = rs8[ai * 4 + m] * qscale;
                f32x4 a0 = acc[ai][0][m][0] * rsd, a1 = acc[ai][0][m][1] * rsd, b0 = acc[ai][1][m][0] * rsd, b1 = acc[ai][1][m][1] * rsd;
                if (is_diff) {
                    float ss = (a0[0] * a0[0] + a0[1] * a0[1]) + (a0[2] * a0[2] + a0[3] * a0[3]);
                    ss += (a1[0] * a1[0] + a1[1] * a1[1]) + (a1[2] * a1[2] + a1[3] * a1[3]);
                    ss += (b0[0] * b0[0] + b0[1] * b0[1]) + (b0[2] * b0[2] + b0[3] * b0[3]);
                    ss += (b1[0] * b1[0] + b1[1] * b1[1]) + (b1[2] * b1[2] + b1[3] * b1[3]);
                    ss += __shfl_xor(ss, 16); ss += __shfl_xor(ss, 32);
                    const float rn = __builtin_amdgcn_rsqf(ss * (1.0f / 64.0f) + 1e-6f);
                    a0 = a0 * rn * g1a; a1 = a1 * rn * g1b; b0 = b0 * rn * g2a; b1 = b1 * rn * g2b;
                    const f32x4 c0 = cs[0], c1 = cs[1], s0 = cs[2], s1 = cs[3];
                    const f32x4 na0 = a0 * c0 - b0 * s0, nb0 = a0 * s0 + b0 * c0, na1 = a1 * c1 - b1 * s1, nb1 = a1 * s1 + b1 * c1;
                    a0 = na0; a1 = na1; b0 = nb0; b1 = nb1;
                }
                bf16_t* rowp = O + (size_t)row * 2048 + col0;
                const u32x4 wa = pack8(a0, a1), wb = pack8(b0, b1);
                if (is_diff && ai * 4 + m + 1 < 8) QK_LOAD(ai * 4 + m + 1);
                __builtin_nontemporal_store(wa, (u32x4*)(rowp));
                __builtin_nontemporal_store(wb, (u32x4*)(rowp + 32));
            }
#undef QK_LOAD
    }
};
struct EpiVt {
    static constexpr bool PERM = true, AFTER_DRAIN = false;
    bf16_t* O; const float* rstd;
    __device__ __forceinline__ void operator()(const f32x4 (&acc)[2][2][4][2], const Unit& u, int wr, int wc, int fr, int fq) const {
        const int ch0 = u.pm * BM + wr * 64 + fr; const int col0 = u.pn * BM + wc * 32 + 8 * fq;
        const bool dif = u.pm >= 2;
        f32x4 sc[2][2];
#pragma unroll
        for (int bj = 0; bj < 2; ++bj)
#pragma unroll
            for (int n = 0; n < 2; ++n) sc[bj][n] = *(const f32x4*)(rstd + col0 + bj * HALF + 4 * n);
#pragma unroll
        for (int ai = 0; ai < 2; ++ai)
#pragma unroll
            for (int m = 0; m < 4; ++m) { const int c = ch0 + ai * HALF + m * 16;
#pragma unroll
                for (int bj = 0; bj < 2; ++bj) { const int tok = col0 + bj * HALF; const int bt = tok >> 6, kv = tok & 63;
                    const size_t off = dif ? (size_t)512 * 65536 + ((size_t)(bt * 4 + ((c - 512) >> 7)) * 128 + ((c - 512) & 127)) * 64 + kv
                                           : ((size_t)(bt * 8 + (c >> 6)) * 64 + (c & 63)) * 64 + kv;
                    __builtin_nontemporal_store(pack8(acc[ai][bj][m][0] * sc[bj][0], acc[ai][bj][m][1] * sc[bj][1]), (u32x4*)(O + off)); } }
    }
};
struct EpiWo {
    static constexpr bool PERM = true, AFTER_DRAIN = false;
    const float* x; bf16_t* xb; float* ss2;
    __device__ __forceinline__ void operator()(const f32x4 (&acc)[2][2][4][2], const Unit& u, int wr, int wc, int fr, int fq) const {
        const int col0 = u.pn * BM + wc * 32 + 8 * fq;
        f32x4 xv[4];
#define WO_LOAD(IT) { const size_t off_ = (size_t)(u.pm * BM + ((IT) >> 2) * HALF + wr * 64 + ((IT) & 3) * 16 + fr) * 1024 + col0; \
            xv[0] = __builtin_nontemporal_load((const f32x4*)(x + off_)); xv[1] = __builtin_nontemporal_load((const f32x4*)(x + off_ + 4)); xv[2] = __builtin_nontemporal_load((const f32x4*)(x + off_ + HALF)); xv[3] = __builtin_nontemporal_load((const f32x4*)(x + off_ + HALF + 4)); }
        WO_LOAD(0);
#pragma unroll
        for (int it = 0; it < 8; ++it) {
            const int ai = it >> 2, m = it & 3;
            const int row = u.pm * BM + ai * HALF + wr * 64 + m * 16 + fr; const size_t off = (size_t)row * 1024 + col0; float ss = 0.f;
            u32x4 wq[2];
#pragma unroll
            for (int bj = 0; bj < 2; ++bj) {
                const f32x4 v0 = xv[2 * bj] + acc[ai][bj][m][0], v1 = xv[2 * bj + 1] + acc[ai][bj][m][1];
                ss += ((v0[0] * v0[0] + v0[1] * v0[1]) + (v0[2] * v0[2] + v0[3] * v0[3])) + ((v1[0] * v1[0] + v1[1] * v1[1]) + (v1[2] * v1[2] + v1[3] * v1[3]));
                wq[bj] = pack8(v0, v1); }
            ss += __shfl_xor(ss, 16); ss += __shfl_xor(ss, 32);
            if (it + 1 < 8) WO_LOAD(it + 1);
            *(u32x4*)(xb + off) = wq[0]; *(u32x4*)(xb + off + HALF) = wq[1];
            if (fq == 0) atomicAdd(ss2 + row, ss);
        }
#undef WO_LOAD
    }
};
struct EpiGU {
    static constexpr bool PERM = true, AFTER_DRAIN = false;
    bf16_t* H; const float* ss2;
    __device__ __forceinline__ void operator()(const f32x4 (&acc)[2][2][4][2], const Unit& u, int wr, int wc, int fr, int fq) const {
        const int col0 = u.pn * 128 + wc * 32 + 8 * fq;
        float sq[8];
#pragma unroll
        for (int it = 0; it < 8; ++it) sq[it] = ss2[u.pm * BM + (it >> 2) * HALF + wr * 64 + (it & 3) * 16 + fr];
#pragma unroll
        for (int ai = 0; ai < 2; ++ai)
#pragma unroll
            for (int m = 0; m < 4; ++m) {
                const int row = u.pm * BM + ai * HALF + wr * 64 + m * 16 + fr;
                const float rsd = __builtin_amdgcn_rsqf(sq[ai * 4 + m] * (1.0f / 1024.0f) + 1e-6f);
                const float ka = -1.4426950408889634f * rsd, r2 = rsd * rsd;
                f32x4 hv[2];
#pragma unroll
                for (int n = 0; n < 2; ++n) { const f32x4 ag = acc[ai][0][m][n], au = acc[ai][1][m][n];
                    const f32x4 ea = ag * ka; f32x4 ex;
#pragma unroll
                    for (int j = 0; j < 4; ++j) ex[j] = __builtin_amdgcn_exp2f(ea[j]);
                    const f32x4 den = ex + 1.0f; f32x4 rc;
#pragma unroll
                    for (int j = 0; j < 4; ++j) rc[j] = __builtin_amdgcn_rcpf(den[j]);
                    hv[n] = ((ag * au) * r2) * rc; }
                __builtin_nontemporal_store(pack8(hv[0], hv[1]), (u32x4*)(H + (size_t)row * 2816 + col0));
            }
    }
};
struct EpiDown {
    static constexpr bool PERM = false, AFTER_DRAIN = false;
    float* out; const bf16_t* xb;
    __device__ __forceinline__ void operator()(const f32x4 (&acc)[2][2][4][2], const Unit& u, int wr, int wc, int fr, int fq) const {
        typedef unsigned u32x2v __attribute__((ext_vector_type(2)));
        const int col0 = u.pn * BM + wc * 32 + 4 * fq;
        u32x2v xw[4];
#define DN_LOAD(IT) { const size_t off_ = (size_t)(u.pm * BM + ((IT) >> 2) * HALF + wr * 64 + ((IT) & 3) * 16 + fr) * 1024 + col0; \
            xw[0] = *(const u32x2v*)(xb + off_); xw[1] = *(const u32x2v*)(xb + off_ + 16); xw[2] = *(const u32x2v*)(xb + off_ + HALF); xw[3] = *(const u32x2v*)(xb + off_ + HALF + 16); }
        DN_LOAD(0);
#pragma unroll
        for (int it = 0; it < 8; ++it) {
            const int ai = it >> 2, m = it & 3;
            const size_t off = (size_t)(u.pm * BM + ai * HALF + wr * 64 + m * 16 + fr) * 1024 + col0;
            f32x4 rv[4];
#pragma unroll
            for (int q = 0; q < 4; ++q) { const u32x2v w = xw[q];
                f32x4 r; r[0] = __uint_as_float(w.x << 16); r[1] = __uint_as_float(w.x & 0xffff0000u); r[2] = __uint_as_float(w.y << 16); r[3] = __uint_as_float(w.y & 0xffff0000u);
                rv[q] = r + acc[ai][q >> 1][m][q & 1]; }
            if (it + 1 < 8) DN_LOAD(it + 1);
#pragma unroll
            for (int q = 0; q < 4; ++q) __builtin_nontemporal_store(rv[q], (f32x4*)(out + off + (q >> 1) * HALF + (q & 1) * 16));
        }
#undef DN_LOAD
    }
};

template <class Epi, class Sched, bool ALIGN_EPI = false, bool SP2 = false>
__device__ __forceinline__ void gemm_phase(PG8_LAS unsigned char* lds, const Gemm g, const Sched& S, const Epi& E) {
    const int tid = threadIdx.x, wid = __builtin_amdgcn_readfirstlane(tid >> 6), lane = tid & 63, wr = wid >> 2, wc = wid & 3, fr = lane & 15, fq = lane >> 4;
    const int K = g.K, nt = K / BK;
    unsigned voffA[2], voffB[2];
#pragma unroll
    for (int i = 0; i < 2; ++i) { int R, C; stage_rc(tid * 16 + i * 8192, R, C); const int Rb = Epi::PERM ? ((R & ~31) + perm32(R & 31)) : R;
        voffA[i] = (unsigned)(R * K + C) * 2u; voffB[i] = (unsigned)(Rb * K + C) * 2u; }
    const size_t kstep = (size_t)(BK * 2);
    const size_t hstep = (size_t)HALF * K * 2;
    const size_t tstep = 2 * hstep;
    const unsigned ldsw = (unsigned)wid * 1024u;
    const int aoff = lds_byte(wr * 64 + fr, fq * 8), boff = lds_byte(wc * 32 + fr, fq * 8);
#define PG8_SA(b, h) (((b) * 2 + (h)) * HTB)
#define PG8_SB(b, h) ((4 + (b) * 2 + (h)) * HTB)
#define PG8_STAGE(bufoff, gbase, voff) do { _Pragma("unroll") for (int _i = 0; _i < 2; ++_i) \
        __builtin_amdgcn_global_load_lds((const unsigned*)((const char*)(gbase) + (voff)[_i]), (PG8_LAS unsigned*)(lds + (bufoff) + ldsw + _i * 8192), 16, 0, 0); } while (0)
#define PG8_LDA(dst, b, h) do { _Pragma("unroll") for (int m = 0; m < 4; ++m) _Pragma("unroll") for (int k = 0; k < 2; ++k) dst[m][k] = *(const PG8_LAS bf16x8*)(lds + PG8_SA(b, h) + aoff + m * 2048 + k * 1024); } while (0)
#define PG8_LDB(dst, b, h) do { _Pragma("unroll") for (int n = 0; n < 2; ++n) _Pragma("unroll") for (int k = 0; k < 2; ++k) dst[n][k] = *(const PG8_LAS bf16x8*)(lds + PG8_SB(b, h) + boff + n * 2048 + k * 1024); } while (0)
#define PG8_MMA(ai, bj, At, Bt) do { __builtin_amdgcn_s_setprio(1); _Pragma("unroll") for (int m = 0; m < 4; ++m) _Pragma("unroll") for (int n = 0; n < 2; ++n) _Pragma("unroll") for (int k = 0; k < 2; ++k) \
        acc[ai][bj][m][n] = __builtin_amdgcn_mfma_f32_16x16x32_bf16(Bt[n][k], At[m][k], acc[ai][bj][m][n], 0, 0, 0); __builtin_amdgcn_s_setprio(0); } while (0)
#define PG8_WAIT_V(n) asm volatile("s_waitcnt vmcnt(" #n ")" ::: "memory")
#define PG8_WAIT_L(n) asm volatile("s_waitcnt lgkmcnt(" #n ")" ::: "memory")
#define PG8_BAR __builtin_amdgcn_s_barrier()
#define PG8_SCHED __builtin_amdgcn_sched_barrier(0)
    Unit cur, nxt; int ui = 0;
    if (!S.next(0, cur)) return;
    f32x4 acc[2][2][4][2];
#pragma unroll
    for (int a = 0; a < 2; ++a)
#pragma unroll
        for (int b = 0; b < 2; ++b)
#pragma unroll
            for (int m = 0; m < 4; ++m)
#pragma unroll
                for (int n = 0; n < 2; ++n) acc[a][b][m][n] = (f32x4){0.f, 0.f, 0.f, 0.f};
    bf16x8 At[4][2], B0[2][2], B1[2][2];
    const char* cA = (const char*)g.A + (size_t)cur.pm * tstep; const char* cB = (const char*)g.Bt + (size_t)cur.pn * tstep;
    S.a_ready(cur);
    if constexpr (SP2) {
        PG8_STAGE(PG8_SB(0, 0), cB, voffB); PG8_STAGE(PG8_SB(0, 1), cB + hstep, voffB); PG8_STAGE(PG8_SA(0, 0), cA, voffA); PG8_STAGE(PG8_SA(0, 1), cA + hstep, voffA);
        if (wr == 1) PG8_BAR;
        PG8_WAIT_V(2); PG8_BAR;
        PG8_STAGE(PG8_SB(1, 0), cB + kstep, voffB); PG8_STAGE(PG8_SA(1, 0), cA + kstep, voffA); PG8_STAGE(PG8_SB(1, 1), cB + hstep + kstep, voffB);
        PG8_WAIT_V(6); PG8_BAR;
    } else {
        PG8_STAGE(PG8_SB(0, 0), cB, voffB); PG8_STAGE(PG8_SA(0, 0), cA, voffA); PG8_STAGE(PG8_SB(0, 1), cB + hstep, voffB); PG8_STAGE(PG8_SA(0, 1), cA + hstep, voffA);
        if (wr == 1) PG8_BAR;
        PG8_WAIT_V(4); PG8_BAR;
        PG8_STAGE(PG8_SB(1, 0), cB + kstep, voffB); PG8_STAGE(PG8_SA(1, 0), cA + kstep, voffA); PG8_STAGE(PG8_SB(1, 1), cB + hstep + kstep, voffB);
        PG8_WAIT_V(6); PG8_BAR;
    }
    for (;;) {
        const bool has_next = S.next(ui + 1, nxt);
        const char* nA = has_next ? (const char*)g.A + (size_t)nxt.pm * tstep : cA; const char* nB = has_next ? (const char*)g.Bt + (size_t)nxt.pn * tstep : cB;
        for (int t = 0; t < nt; t += 2) {
            const bool last = (t == nt - 2);
            const char* a1 = cA + (size_t)(t + 1) * kstep;
            const char* a2 = last ? nA : cA + (size_t)(t + 2) * kstep; const char* b2 = last ? nB : cB + (size_t)(t + 2) * kstep;
            const char* a3 = a2 + kstep; const char* b3 = b2 + kstep;
            if (last && has_next) S.a_ready(nxt);
            if constexpr (SP2) {
            PG8_LDB(B0, 0, 0); PG8_LDB(B1, 0, 1); PG8_SCHED; PG8_LDA(At, 0, 0); PG8_STAGE(PG8_SA(1, 1), a1 + hstep, voffA);
            PG8_WAIT_V(8); PG8_WAIT_L(0); PG8_BAR; PG8_MMA(0, 0, At, B0); PG8_MMA(0, 1, At, B1); PG8_BAR; PG8_SCHED;
            PG8_LDA(At, 0, 1); PG8_STAGE(PG8_SB(0, 0), b2, voffB); PG8_STAGE(PG8_SB(0, 1), b2 + hstep, voffB); PG8_STAGE(PG8_SA(0, 0), a2, voffA);
            PG8_WAIT_V(8); PG8_WAIT_L(0); PG8_BAR; PG8_MMA(1, 0, At, B0); PG8_MMA(1, 1, At, B1); PG8_BAR; PG8_SCHED;
            PG8_LDB(B0, 1, 0); PG8_LDB(B1, 1, 1); PG8_SCHED; PG8_LDA(At, 1, 0); PG8_STAGE(PG8_SA(0, 1), a2 + hstep, voffA);
            PG8_WAIT_V(8); PG8_WAIT_L(0); PG8_BAR; PG8_MMA(0, 0, At, B0); PG8_MMA(0, 1, At, B1); PG8_BAR; PG8_SCHED;
            PG8_LDA(At, 1, 1); PG8_STAGE(PG8_SB(1, 0), b3, voffB); PG8_STAGE(PG8_SB(1, 1), b3 + hstep, voffB); PG8_STAGE(PG8_SA(1, 0), a3, voffA);
            PG8_WAIT_V(8); PG8_WAIT_L(0); PG8_BAR; PG8_MMA(1, 0, At, B0); PG8_MMA(1, 1, At, B1); PG8_BAR; PG8_SCHED;
            } else {
            PG8_LDB(B0, 0, 0); PG8_SCHED; PG8_LDA(At, 0, 0); PG8_STAGE(PG8_SA(1, 1), a1 + hstep, voffA);
            PG8_WAIT_L(8); PG8_BAR; PG8_WAIT_L(0); PG8_MMA(0, 0, At, B0); PG8_BAR; PG8_SCHED;
            PG8_LDB(B1, 0, 1); PG8_STAGE(PG8_SB(0, 0), b2, voffB);
            PG8_BAR; PG8_WAIT_L(0); PG8_MMA(0, 1, At, B1); PG8_BAR;
            PG8_LDA(At, 0, 1); PG8_STAGE(PG8_SA(0, 0), a2, voffA);
            PG8_BAR; PG8_WAIT_L(0); PG8_MMA(1, 0, At, B0); PG8_BAR; PG8_SCHED;
            PG8_STAGE(PG8_SB(0, 1), b2 + hstep, voffB);
            PG8_WAIT_V(6); PG8_BAR; PG8_MMA(1, 1, At, B1); PG8_BAR;
            PG8_LDB(B0, 1, 0); PG8_SCHED; PG8_LDA(At, 1, 0); PG8_STAGE(PG8_SA(0, 1), a2 + hstep, voffA);
            PG8_WAIT_L(8); PG8_BAR; PG8_WAIT_L(0); PG8_MMA(0, 0, At, B0); PG8_BAR; PG8_SCHED;
            PG8_LDB(B1, 1, 1); PG8_STAGE(PG8_SB(1, 0), b3, voffB);
            PG8_BAR; PG8_WAIT_L(0); PG8_MMA(0, 1, At, B1); PG8_BAR;
            PG8_LDA(At, 1, 1); PG8_STAGE(PG8_SA(1, 0), a3, voffA);
            PG8_BAR; PG8_WAIT_L(0); PG8_MMA(1, 0, At, B0); PG8_BAR; PG8_SCHED;
            PG8_STAGE(PG8_SB(1, 1), b3 + hstep, voffB);
            PG8_WAIT_V(6); PG8_BAR; PG8_MMA(1, 1, At, B1); PG8_BAR;
            }
        }
        if constexpr (ALIGN_EPI) { if (wr == 0) PG8_BAR; }
        if constexpr (!Epi::AFTER_DRAIN) { E(acc, cur, wr, wc, fr, fq); S.done(cur); }
        if (!has_next) break;
#pragma unroll
        for (int a = 0; a < 2; ++a)
#pragma unroll
            for (int b = 0; b < 2; ++b)
#pragma unroll
                for (int m = 0; m < 4; ++m)
#pragma unroll
                    for (int n = 0; n < 2; ++n) acc[a][b][m][n] = (f32x4){0.f, 0.f, 0.f, 0.f};
        cur = nxt; cA = nA; cB = nB; ++ui;
        if constexpr (ALIGN_EPI) { if (wr == 1) PG8_BAR; }
    }
    PG8_WAIT_V(0);
    if constexpr (!ALIGN_EPI) { if (wr == 0) PG8_BAR; }
    PG8_BAR;
    if constexpr (Epi::AFTER_DRAIN) { E.fused(acc, cur, wr, wc, fr, fq, lds, wid, lane); S.done(cur); }
#undef PG8_SA
#undef PG8_SB
#undef PG8_STAGE
#undef PG8_LDA
#undef PG8_LDB
#undef PG8_MMA
#undef PG8_WAIT_V
#undef PG8_WAIT_L
#undef PG8_BAR
#undef PG8_SCHED
}
}

namespace att {
#define LAS __attribute__((address_space(3)))
typedef unsigned short bf16_t;
typedef short bf16x8 __attribute__((ext_vector_type(8)));
typedef float f32x16 __attribute__((ext_vector_type(16)));
typedef float f32x4 __attribute__((ext_vector_type(4)));
typedef unsigned u32x4 __attribute__((ext_vector_type(4)));
typedef unsigned u32x2 __attribute__((ext_vector_type(2)));
typedef float f32x2 __attribute__((ext_vector_type(2)));
constexpr int SEQ = 2048, MTOK = 65536, NQK = 2048, DMIX = 1024;
constexpr float C2 = 0.125f * 1.4426950408889634f;
#define MFMA32(a, b, c) __builtin_amdgcn_mfma_f32_32x32x16_bf16((a), (b), (c), 0, 0, 0)
__device__ __forceinline__ int crow(int r, int hi) { return (r & 3) + 8 * (r >> 2) + 4 * hi; }
__device__ __forceinline__ int swap23(int i) { return (i & 0x13) | ((i & 4) << 1) | ((i & 8) >> 1); }
typedef float f32x2_cv __attribute__((ext_vector_type(2))); typedef __bf16 bf16x2_cv __attribute__((ext_vector_type(2)));
__device__ __forceinline__ unsigned cvtpk(float lo, float hi) { f32x2_cv v = {lo, hi}; bf16x2_cv b = __builtin_convertvector(v, bf16x2_cv); return __builtin_bit_cast(unsigned, b); }
__device__ __forceinline__ void halves(float x, float& lo, float& up) { auto rr = __builtin_amdgcn_permlane32_swap(__float_as_uint(x), __float_as_uint(x), false, false); lo = __uint_as_float(rr[0]); up = __uint_as_float(rr[1]); }

constexpr int SB_ROW = 144, SB_SLOT = 2 * 9216, SB_NSLOT = 6, SB_FLAGS = SB_NSLOT * SB_SLOT, SB_VTILE = 8 * 64 * 64  ;
__device__ __forceinline__ void sb_tile(const LAS unsigned char* Sb, int kfo, int vfo, const bf16x8 (&qf)[4], f32x16& o0, f32x16& o1, float& R, bool diag, int t, int hi, int qrow) {
    f32x16 p0, p1;
#pragma unroll
    for (int r = 0; r < 16; ++r) { p0[r] = 0.f; p1[r] = 0.f; }
#pragma unroll
    for (int d0 = 0; d0 < 4; ++d0) {
        const bf16x8 a0 = *(const LAS bf16x8*)(Sb + kfo + d0 * 32), a1 = *(const LAS bf16x8*)(Sb + kfo + 32 * SB_ROW + d0 * 32);
        p0 = MFMA32(a0, qf[d0], p0); p1 = MFMA32(a1, qf[d0], p1);
    }
    float cc[32], bb[32];
#pragma unroll
    for (int i = 0; i < 32; ++i) {
        const int p = i >> 4, r = i & 15;
        const float s = __builtin_amdgcn_fmed3f(p ? p1[r] : p0[r], -126.0f, 126.0f);
        const float E = __builtin_amdgcn_exp2f(s);
        const float c1 = __builtin_amdgcn_rcpf(1.0f + E);
        cc[i] = c1;
        bb[i] = E * c1;
    }
    if (diag) {
        asm volatile("" ::: "memory");
        const int kvb = 64 * t + 8 * hi;
#pragma unroll
        for (int i = 0; i < 32; ++i) { const int kv = kvb + 32 * (i >> 4) + (i & 7) + 16 * ((i & 15) >> 3); if (kv >= qrow) { bb[i] = 0.f; cc[i] = 1.f; } }
    }
    float ex[32], T[4];
#pragma unroll
    for (int k = 0; k < 4; ++k) {
        ex[8 * k + 7] = 1.f;
#pragma unroll
        for (int i = 6; i >= 0; --i) ex[8 * k + i] = ex[8 * k + i + 1] * cc[8 * k + i + 1];
        T[k] = ex[8 * k] * cc[8 * k];
    }
    float tl[4], tu[4];
#pragma unroll
    for (int k = 0; k < 4; ++k) halves(T[k], tl[k], tu[k]);
    float offl[4], offu[4]; float run = R;
#pragma unroll
    for (int k = 3; k >= 0; --k) { offu[k] = run; run *= tu[k]; offl[k] = run; run *= tl[k]; }
    R = run;
    u32x4 pa[4];
#pragma unroll
    for (int k = 0; k < 4; ++k) {
        const float off = hi ? offu[k] : offl[k];
        float w[8];
#pragma unroll
        for (int i = 0; i < 8; ++i) w[i] = bb[8 * k + i] * (off * ex[8 * k + i]);
        pa[k].x = cvtpk(w[0], w[1]); pa[k].y = cvtpk(w[2], w[3]); pa[k].z = cvtpk(w[4], w[5]); pa[k].w = cvtpk(w[6], w[7]);
    }
#pragma unroll
    for (int m = 0; m < 4; ++m) {
        const bf16x8 v0 = *(const LAS bf16x8*)(Sb + vfo + m * 32), v1 = *(const LAS bf16x8*)(Sb + vfo + 32 * SB_ROW + m * 32);
        o0 = MFMA32(v0, __builtin_bit_cast(bf16x8, pa[m]), o0); o1 = MFMA32(v1, __builtin_bit_cast(bf16x8, pa[m]), o1);
    }
}
__device__ __forceinline__ void sb_job(LAS unsigned char* lds, const bf16_t* __restrict__ QK, const bf16_t* __restrict__ Vt, bf16_t* __restrict__ MIX, int b, int h) {
    const int tid = threadIdx.x, lane = tid & 63, r32 = lane & 31, hi = lane >> 5;
    const int wid = __builtin_amdgcn_readfirstlane(tid >> 6);
    const int tok0 = b * SEQ;
    const int srow = tid >> 3, sch = tid & 7;
    const bf16_t* kg = QK + (size_t)(tok0 + srow) * NQK + 512 + h * 64 + sch * 8;
    const bf16_t* vg = Vt + ((size_t)(b * 32 * 8 + h) * 64 + srow) * 64 + sch * 8;
    const bf16_t* Qb = QK + (size_t)(tok0 + wid * 32 + r32) * NQK + h * 64 + hi * 8;
    const int sdst = srow * SB_ROW + sch * 16;
    const int kfo = swap23(r32) * SB_ROW + hi * 16, vfo = 9216 + r32 * SB_ROW + hi * 16;
    LAS unsigned* flags = (LAS unsigned*)(lds + SB_FLAGS);
    bf16x8 qfn[4]; u32x4 kr[4], vr[4], kAn, vAn;
#define SB_PRELOAD(QB) { const int t0_ = 4 * (QB); \
        _Pragma("unroll") for (int d0 = 0; d0 < 4; ++d0) qfn[d0] = *(const bf16x8*)(Qb + (size_t)(QB) * 256 * NQK + 16 * d0); \
        _Pragma("unroll") for (int i = 0; i < 4; ++i) { kr[i] = *(const u32x4*)(kg + (size_t)(t0_ + i) * 64 * NQK); vr[i] = *(const u32x4*)(vg + (size_t)(t0_ + i) * SB_VTILE); } \
        if (t0_ >= 1) { kAn = *(const u32x4*)(kg + (size_t)(t0_ - 1) * 64 * NQK); vAn = *(const u32x4*)(vg + (size_t)(t0_ - 1) * SB_VTILE); } }
    SB_PRELOAD(0);
    for (int ui = 0; ui < 8; ++ui) {
    const int qb = (ui & 1) ? 7 - (ui >> 1) : (ui >> 1);
    const int qrow = qb * 256 + wid * 32 + r32;
    bf16x8 qf[4];
#pragma unroll
    for (int d0 = 0; d0 < 4; ++d0) qf[d0] = qfn[d0];
    const int T0 = 4 * qb, td = T0 + (wid >> 1);
    f32x16 o0, o1;
#pragma unroll
    for (int r = 0; r < 16; ++r) { o0[r] = 0.f; o1[r] = 0.f; }
    float R = 1.f;
    const int s0 = T0 % SB_NSLOT;
    u32x4 kA = kAn, vA = vAn, kB, vB;
#pragma unroll
    for (int i = 0; i < 4; ++i) { int sl = s0 + i; sl = sl >= SB_NSLOT ? sl - SB_NSLOT : sl; *(LAS u32x4*)(lds + sl * SB_SLOT + sdst) = kr[i]; *(LAS u32x4*)(lds + sl * SB_SLOT + 9216 + sdst) = vr[i]; }
    __syncthreads();
    int myslot = s0 + (wid >> 1); myslot = myslot >= SB_NSLOT ? myslot - SB_NSLOT : myslot;
    int pslot = s0 == 0 ? SB_NSLOT - 1 : s0 - 1;
    bool wdone = false, alld = false;
#define SB_STEP(J, KW, VW, KL, VL) { \
        const int t_ = td - (J), tw_ = T0 - (J) - 1, tl_ = T0 - (J) - 2; \
        if (tl_ >= 0) { KL = *(const u32x4*)(kg + (size_t)tl_ * 64 * NQK); VL = *(const u32x4*)(vg + (size_t)tl_ * SB_VTILE); } \
        if (t_ >= 0 && !wdone) { sb_tile(lds + myslot * SB_SLOT, kfo, vfo, qf, o0, o1, R, (J) == 0, t_, hi, qrow); wdone = __all(R == 0.0f);   } \
        const bool fin_ = wdone || (t_ <= 0); \
        if (lane == 0) flags[((J) & 1) * 8 + wid] = fin_ ? 1u : 0u; \
        if (tw_ >= 0) { *(LAS u32x4*)(lds + pslot * SB_SLOT + sdst) = KW; *(LAS u32x4*)(lds + pslot * SB_SLOT + 9216 + sdst) = VW; } \
        __syncthreads(); \
        alld = __all(flags[((J) & 1) * 8 + (lane & 7)] != 0u); \
        myslot = myslot == 0 ? SB_NSLOT - 1 : myslot - 1; pslot = pslot == 0 ? SB_NSLOT - 1 : pslot - 1; }
    for (int j = 0;; j += 2) {
        SB_STEP(j, kA, vA, kB, vB);
        if (alld) break;
        SB_STEP(j + 1, kB, vB, kA, vA);
        if (alld) break;
    }
#undef SB_STEP
    if (ui + 1 < 8) { const int qn = ((ui + 1) & 1) ? 7 - ((ui + 1) >> 1) : ((ui + 1) >> 1); SB_PRELOAD(qn); }
    LAS unsigned char* stg = lds + wid * (32 * 144);
#pragma unroll
    for (int g4 = 0; g4 < 4; ++g4) {
        u32x2 w0, w1; w0.x = cvtpk(o0[4 * g4], o0[4 * g4 + 1]); w0.y = cvtpk(o0[4 * g4 + 2], o0[4 * g4 + 3]); w1.x = cvtpk(o1[4 * g4], o1[4 * g4 + 1]); w1.y = cvtpk(o1[4 * g4 + 2], o1[4 * g4 + 3]);
        *(LAS u32x2*)(stg + r32 * 144 + (8 * g4 + 4 * hi) * 2) = w0; *(LAS u32x2*)(stg + r32 * 144 + 64 + (8 * g4 + 4 * hi) * 2) = w1;
    }
    asm volatile("s_waitcnt lgkmcnt(0)" ::: "memory");
    bf16_t* Ow = MIX + (size_t)(tok0 + qb * 256 + wid * 32) * DMIX + h * 64;
#pragma unroll
    for (int i = 0; i < 4; ++i) { const int row = 8 * i + (lane >> 3), ch = lane & 7;
        const u32x4 v = *(const LAS u32x4*)(stg + row * 144 + ch * 16);
        *(u32x4*)(Ow + (size_t)row * DMIX + ch * 8) = v; }
    __syncthreads();
    }
#undef SB_PRELOAD
}

constexpr int DF_KROW = 272, DF_KBUF = 64 * 272, DF_VROW = 144, DF_VBUF = 128 * 144, DF_KS = 0, DF_VS = 2 * DF_KBUF;
__device__ __forceinline__ void diff_tile(const LAS unsigned char* Kb, const LAS unsigned char* Vb, int kfo, int vfo, const bf16x8 (&qf)[4], f32x16 (&o)[4], float& mrun, float& lsum, bool diag, int kvb, int qrow) {
#define SCHED_FENCE() __builtin_amdgcn_sched_barrier(0)
    bf16x8 kf[8];
#pragma unroll
    for (int d0 = 0; d0 < 4; ++d0) { kf[2 * d0] = *(const LAS bf16x8*)(Kb + kfo + d0 * 32); kf[2 * d0 + 1] = *(const LAS bf16x8*)(Kb + kfo + 32 * DF_KROW + d0 * 32); }
    SCHED_FENCE();
    f32x16 p0, p1;
#pragma unroll
    for (int r = 0; r < 16; ++r) { p0[r] = 0.f; p1[r] = 0.f; }
#pragma unroll
    for (int d0 = 0; d0 < 4; ++d0) { p0 = MFMA32(kf[2 * d0], qf[d0], p0); p1 = MFMA32(kf[2 * d0 + 1], qf[d0], p1); }
    SCHED_FENCE();
    if (diag) {
        asm volatile("" ::: "memory");
#pragma unroll
        for (int r = 0; r < 16; ++r) { const int kv = kvb + (r & 7) + 16 * (r >> 3); if (kv > qrow) p0[r] = -1e30f; if (kv + 32 > qrow) p1[r] = -1e30f; }
    }
    float rm = __builtin_fmaxf(p0[0], p1[0]);
#pragma unroll
    for (int r = 1; r < 16; ++r) rm = __builtin_fmaxf(__builtin_fmaxf(rm, p0[r]), p1[r]);
    { float lo, up; halves(rm, lo, up); rm = __builtin_fmaxf(lo, up) * C2; }
    if (__any(rm > mrun + 6.0f)) {
        const float mnew = __builtin_fmaxf(mrun, rm);
        const float alpha = __builtin_amdgcn_exp2f(mrun - mnew); lsum *= alpha;
#pragma unroll
        for (int d0 = 0; d0 < 4; ++d0)
#pragma unroll
            for (int r = 0; r < 16; ++r) o[d0][r] *= alpha;
        mrun = mnew;
    }
    u32x4 pa[4]; f32x2 ls2 = {0.f, 0.f}; const f32x2 c2v = {C2, C2}, nmv = {-mrun, -mrun};
    bf16x8 vf[16];
#define RDV(j) vf[j] = *(const LAS bf16x8*)(Vb + vfo + ((j) & 3) * 32 * DF_VROW + ((j) >> 2) * 32)
#define EXP_PAIR(P, R, DST) do { const f32x2 e_ = (f32x2){P[R], P[(R) + 1]} * c2v + nmv; const f32x2 w_ = (f32x2){__builtin_amdgcn_exp2f(e_[0]), __builtin_amdgcn_exp2f(e_[1])}; ls2 += w_; DST = cvtpk(w_[0], w_[1]); } while (0)
    SCHED_FENCE();
    RDV(0); RDV(1); EXP_PAIR(p0, 0, pa[0].x); EXP_PAIR(p0, 2, pa[0].y); EXP_PAIR(p0, 4, pa[0].z); EXP_PAIR(p0, 6, pa[0].w); SCHED_FENCE();
    RDV(2); o[0] = MFMA32(vf[0], __builtin_bit_cast(bf16x8, pa[0]), o[0]); EXP_PAIR(p0, 8, pa[1].x); SCHED_FENCE();
    RDV(3); o[1] = MFMA32(vf[1], __builtin_bit_cast(bf16x8, pa[0]), o[1]); EXP_PAIR(p0, 10, pa[1].y); SCHED_FENCE();
    RDV(4); o[2] = MFMA32(vf[2], __builtin_bit_cast(bf16x8, pa[0]), o[2]); EXP_PAIR(p0, 12, pa[1].z); SCHED_FENCE();
    RDV(5); o[3] = MFMA32(vf[3], __builtin_bit_cast(bf16x8, pa[0]), o[3]); EXP_PAIR(p0, 14, pa[1].w); SCHED_FENCE();
    RDV(6); o[0] = MFMA32(vf[4], __builtin_bit_cast(bf16x8, pa[1]), o[0]); EXP_PAIR(p1, 0, pa[2].x); SCHED_FENCE();
    RDV(7); o[1] = MFMA32(vf[5], __builtin_bit_cast(bf16x8, pa[1]), o[1]); EXP_PAIR(p1, 2, pa[2].y); SCHED_FENCE();
    RDV(8); o[2] = MFMA32(vf[6], __builtin_bit_cast(bf16x8, pa[1]), o[2]); EXP_PAIR(p1, 4, pa[2].z); SCHED_FENCE();
    RDV(9); o[3] = MFMA32(vf[7], __builtin_bit_cast(bf16x8, pa[1]), o[3]); EXP_PAIR(p1, 6, pa[2].w); SCHED_FENCE();
    RDV(10); o[0] = MFMA32(vf[8], __builtin_bit_cast(bf16x8, pa[2]), o[0]); EXP_PAIR(p1, 8, pa[3].x); SCHED_FENCE();
    RDV(11); o[1] = MFMA32(vf[9], __builtin_bit_cast(bf16x8, pa[2]), o[1]); EXP_PAIR(p1, 10, pa[3].y); SCHED_FENCE();
    RDV(12); o[2] = MFMA32(vf[10], __builtin_bit_cast(bf16x8, pa[2]), o[2]); EXP_PAIR(p1, 12, pa[3].z); SCHED_FENCE();
    RDV(13); o[3] = MFMA32(vf[11], __builtin_bit_cast(bf16x8, pa[2]), o[3]); EXP_PAIR(p1, 14, pa[3].w); SCHED_FENCE();
    RDV(14); o[0] = MFMA32(vf[12], __builtin_bit_cast(bf16x8, pa[3]), o[0]); SCHED_FENCE();
    RDV(15); o[1] = MFMA32(vf[13], __builtin_bit_cast(bf16x8, pa[3]), o[1]); SCHED_FENCE();
    o[2] = MFMA32(vf[14], __builtin_bit_cast(bf16x8, pa[3]), o[2]); SCHED_FENCE();
    o[3] = MFMA32(vf[15], __builtin_bit_cast(bf16x8, pa[3]), o[3]); SCHED_FENCE();
#undef EXP_PAIR
#undef RDV
    lsum += ls2[0] + ls2[1];
#undef SCHED_FENCE
}
__device__ __forceinline__ void diff_unit(LAS unsigned char* lds, const bf16_t* __restrict__ QK, const bf16_t* __restrict__ Vt, bf16_t* __restrict__ MIX, const float* __restrict__ gsub, float lam, int b, int h, int qb) {
    const int tid = threadIdx.x, lane = tid & 63, r32 = lane & 31, hi = lane >> 5;
    const int wid = __builtin_amdgcn_readfirstlane(tid >> 6);
    const int c = wid >> 2, g = wid & 3;
    const int tok0 = b * SEQ;
    const int qrow = qb * 128 + g * 32 + r32;
    const bf16_t* Qp = QK + (size_t)(tok0 + qrow) * NQK + 1024 + h * 128 + c * 64 + hi * 8;
    bf16x8 qf[4];
#pragma unroll
    for (int d0 = 0; d0 < 4; ++d0) qf[d0] = *(const bf16x8*)(Qp + 16 * d0);
    const int NT = 2 * qb + 2, td = 2 * qb + (g >> 1);
    const bf16_t* kg[2]; const bf16_t* vg[2]; int kd[2], vd[2];
#pragma unroll
    for (int i = 0; i < 2; ++i) { const int idx = tid + 512 * i;
        kg[i] = QK + (size_t)(tok0 + (idx >> 4)) * NQK + 1536 + h * 128 + (idx & 15) * 8; kd[i] = (idx >> 4) * DF_KROW + (idx & 15) * 16;
        vg[i] = Vt + (size_t)512 * 65536 + ((size_t)(b * 32 * 4 + h) * 128 + (idx >> 3)) * 64 + (idx & 7) * 8;        vd[i] = (idx >> 3) * DF_VROW + (idx & 7) * 16; }
    const int kfo = swap23(r32) * DF_KROW + c * 128 + hi * 16, vfo = r32 * DF_VROW + hi * 16;
    f32x16 o[4];
#pragma unroll
    for (int d0 = 0; d0 < 4; ++d0)
#pragma unroll
        for (int r = 0; r < 16; ++r) o[d0][r] = 0.f;
    float mrun = -1e30f, lsum = 0.f;
    u32x4 k0r[2], v0r[2], k1r[2], v1r[2];
#define DF_LOAD(KR, VR, T) do { _Pragma("unroll") for (int i = 0; i < 2; ++i) { KR[i] = *(const u32x4*)(kg[i] + (size_t)(T) * 64 * NQK); VR[i] = *(const u32x4*)(vg[i] + (size_t)(T) * (4 * 128 * 64)); } } while (0)
#define DF_STAGE(KR, VR, BUF) do { _Pragma("unroll") for (int i = 0; i < 2; ++i) { *(LAS u32x4*)(lds + DF_KS + (BUF) * DF_KBUF + kd[i]) = KR[i]; *(LAS u32x4*)(lds + DF_VS + (BUF) * DF_VBUF + vd[i]) = VR[i]; } } while (0)
    DF_LOAD(k0r, v0r, 0); DF_LOAD(k1r, v1r, 1);
    DF_STAGE(k0r, v0r, 0);
    if (NT > 2) DF_LOAD(k0r, v0r, 2);
    __syncthreads();
    const int kvb = 8 * hi;
    for (int t = 0; t < NT; t += 2) {
        if (t <= td) diff_tile(lds + DF_KS, lds + DF_VS, kfo, vfo, qf, o, mrun, lsum, t == td, 64 * t + kvb, qrow);
        DF_STAGE(k1r, v1r, 1);
        if (t + 3 < NT) DF_LOAD(k1r, v1r, t + 3);
        __syncthreads();
        if (t + 1 <= td) diff_tile(lds + DF_KS + DF_KBUF, lds + DF_VS + DF_VBUF, kfo, vfo, qf, o, mrun, lsum, t + 1 == td, 64 * (t + 1) + kvb, qrow);
        if (t + 2 < NT) { DF_STAGE(k0r, v0r, 0); }
        if (t + 4 < NT) DF_LOAD(k0r, v0r, t + 4);
        __syncthreads();
    }
#undef DF_LOAD
#undef DF_STAGE
    float ltot; { float lo, up; halves(lsum, lo, up); ltot = lo + up; }
    LAS float* X = (LAS float*)lds;
    if (c == 1) {
        const float f = lam / ltot;
#pragma unroll
        for (int d0 = 0; d0 < 4; ++d0)
#pragma unroll
            for (int r = 0; r < 16; ++r) X[((g * 4 + d0) * 16 + r) * 64 + lane] = o[d0][r] * f;
    }
    __syncthreads();
    if (c == 0) {
        const float inv = 1.0f / ltot; float ss = 0.f;
#pragma unroll
        for (int d0 = 0; d0 < 4; ++d0)
#pragma unroll
            for (int r = 0; r < 16; ++r) { const float val = o[d0][r] * inv - X[((g * 4 + d0) * 16 + r) * 64 + lane]; o[d0][r] = val; ss += val * val; }
        { float lo, up; halves(ss, lo, up); ss = lo + up; }
        const float rn = 0.8f / sqrtf(ss * (1.0f / 128.0f) + 1e-5f);
        LAS unsigned char* stg = lds + 65536 + g * (32 * 272);
#pragma unroll
        for (int d0 = 0; d0 < 4; ++d0)
#pragma unroll
            for (int g4 = 0; g4 < 4; ++g4) {
                const f32x4 gs = *(const f32x4*)(gsub + 32 * d0 + 8 * g4 + 4 * hi);
                u32x2 w; w.x = cvtpk(o[d0][4 * g4] * rn * gs[0], o[d0][4 * g4 + 1] * rn * gs[1]); w.y = cvtpk(o[d0][4 * g4 + 2] * rn * gs[2], o[d0][4 * g4 + 3] * rn * gs[3]);
                *(LAS u32x2*)(stg + r32 * 272 + (32 * d0 + 8 * g4 + 4 * hi) * 2) = w;
            }
        asm volatile("s_waitcnt lgkmcnt(0)" ::: "memory");
        bf16_t* Ow = MIX + (size_t)(tok0 + qb * 128 + g * 32) * DMIX + 512 + h * 128;
#pragma unroll
        for (int i = 0; i < 8; ++i) { const int row = 4 * i + (lane >> 4), ch = lane & 15;
            const u32x4 v = *(const LAS u32x4*)(stg + row * 272 + ch * 16);
            *(u32x4*)(Ow + (size_t)row * DMIX + ch * 8) = v; }
    }
    __syncthreads();
}
}

#ifndef MK_LAUNCHES
#define MK_LAUNCHES 1
#endif
constexpr int NWAVES = 8;
constexpr int BATCH = 32, SEQ = 2048, DM = 1024, MTOK = BATCH * SEQ, NQK = 2048, NV = 1024, FF = 2816, NGU = 2 * FF;
constexpr size_t MiB = 1u << 20;
constexpr size_t WS_RSTD1 = 0, WS_SS2 = 256 * 1024, WS_ROPEC = 512 * 1024, WS_ROPES = 768 * 1024;
constexpr size_t WS_WQK = 1 * MiB, WS_WV = 5 * MiB, WS_WO = 7 * MiB, WS_WGU = 9 * MiB, WS_WD = 20 * MiB;
constexpr size_t WS_BAR = 26 * MiB;
constexpr size_t WS_XB = 32 * MiB, WS_QK = 160 * MiB, WS_VT = 416 * MiB, WS_H = 160 * MiB, WS_MIX = 544 * MiB, WS_END = 672 * MiB;
static_assert(WS_WD + (size_t)DM * FF * 2 <= WS_XB && WS_H + (size_t)MTOK * FF * 2 <= WS_MIX, "ws map");
constexpr int LDS_BYTES = 131072;

typedef unsigned short bf16_t;
typedef float f32x4 __attribute__((ext_vector_type(4)));
typedef unsigned u32x4 __attribute__((ext_vector_type(4)));
typedef unsigned u32x2 __attribute__((ext_vector_type(2)));

__device__ __forceinline__ float wave_sum(float v) {
#pragma unroll
    for (int o = 1; o < 64; o <<= 1) v += __shfl_xor(v, o);
    return v;
}
__device__ __forceinline__ void p0_transpose_item(const float* __restrict__ W, int Nsrc, int K, int src_col0, int k0, const float* __restrict__ gk, bf16_t* __restrict__ WT, int dst_row0, LAS float* scr, int lane) {
    float wv[32];
#pragma unroll
    for (int i = 0; i < 32; ++i) wv[i] = W[(size_t)(k0 + 2 * i + (lane >> 5)) * Nsrc + src_col0 + (lane & 31)];
#pragma unroll
    for (int i = 0; i < 32; ++i) { const int kk = 2 * i + (lane >> 5); float v = wv[i]; if (gk) v *= gk[k0 + kk]; scr[kk * 33 + (lane & 31)] = v; }
    asm volatile("s_waitcnt lgkmcnt(0)" ::: "memory");
    const int c = lane & 7;
#pragma unroll
    for (int j = 0; j < 4; ++j) { const int n = (lane >> 3) + 8 * j; const LAS float* s = scr + (8 * c) * 33 + n;
        u32x4 o; o.x = pg8::cvt_pk_bf16(s[0 * 33], s[1 * 33]); o.y = pg8::cvt_pk_bf16(s[2 * 33], s[3 * 33]); o.z = pg8::cvt_pk_bf16(s[4 * 33], s[5 * 33]); o.w = pg8::cvt_pk_bf16(s[6 * 33], s[7 * 33]);
        *(u32x4*)(WT + (size_t)(dst_row0 + n) * K + k0 + 8 * c) = o; }
    asm volatile("s_waitcnt lgkmcnt(0)" ::: "memory");
}

__device__ __forceinline__ void grid_bar_fast(unsigned* cnt, unsigned target) {
    asm volatile("s_waitcnt vmcnt(0) lgkmcnt(0)" ::: "memory");
    __syncthreads();
    if (threadIdx.x == 0) {
        __builtin_amdgcn_fence(__ATOMIC_RELEASE, "agent");
        asm volatile("s_waitcnt vmcnt(0)" ::: "memory");
        (void)__hip_atomic_fetch_add(cnt, 1u, __ATOMIC_RELAXED, __HIP_MEMORY_SCOPE_AGENT);
        unsigned spins = 0;
        while (__hip_atomic_load(cnt, __ATOMIC_RELAXED, __HIP_MEMORY_SCOPE_AGENT) < target) { __builtin_amdgcn_s_sleep(2); if (++spins > (1u << 21)) break; }
        __builtin_amdgcn_fence(__ATOMIC_ACQUIRE, "agent");
        asm volatile("s_waitcnt vmcnt(0)" ::: "memory");
    }
    __syncthreads();
}

struct Args {
    const float* x; const float* attn_g; const float* w_in; const float* gq; const float* gk; const float* lq1; const float* lk1; const float* lq2; const float* lk2;
    const float* gsub; const float* w_o; const float* ffn_g; const float* w_gate; const float* w_up; const float* w_down;
    float* out; unsigned char* ws; int ph_lo, ph_hi;
};

__global__ void __launch_bounds__(NWAVES * 64, 2) fwd_megakernel(Args a) {
    extern __shared__ __attribute__((aligned(16))) unsigned char lds_raw[];
    LAS unsigned char* lds = (LAS unsigned char*)lds_raw;
    cg::grid_group grid = cg::this_grid();
    const int tid = threadIdx.x, lane = tid & 63, wave = __builtin_amdgcn_readfirstlane(tid >> 6);
    const int G = gridDim.x, bx = blockIdx.x;
    unsigned char* ws = a.ws;
    float* rstd1 = (float*)(ws + WS_RSTD1); float* ss2 = (float*)(ws + WS_SS2); float* ropec = (float*)(ws + WS_ROPEC); float* ropes = (float*)(ws + WS_ROPES);
    bf16_t* Wqk_t = (bf16_t*)(ws + WS_WQK); bf16_t* Wv_t = (bf16_t*)(ws + WS_WV); bf16_t* Wo_t = (bf16_t*)(ws + WS_WO); bf16_t* Wgu_t = (bf16_t*)(ws + WS_WGU); bf16_t* Wd_t = (bf16_t*)(ws + WS_WD);
    bf16_t* XB = (bf16_t*)(ws + WS_XB); bf16_t* QKb = (bf16_t*)(ws + WS_QK); bf16_t* Vt = (bf16_t*)(ws + WS_VT); bf16_t* HB = (bf16_t*)(ws + WS_H); bf16_t* MIX = (bf16_t*)(ws + WS_MIX);
    unsigned* barcnt = (unsigned*)(ws + WS_BAR);
    const int lo = a.ph_lo, hi = a.ph_hi;
#define IN(k) (lo <= (k) && (k) < hi)
#define SEAM(k) do { if (IN(k) && IN((k) + 1)) { if ((k) == 0) { asm volatile("s_waitcnt vmcnt(0) lgkmcnt(0)" ::: "memory"); grid.sync(); if (tid == 0) { __builtin_amdgcn_fence(__ATOMIC_ACQUIRE, "agent"); asm volatile("s_waitcnt vmcnt(0)" ::: "memory"); } __syncthreads(); } else grid_bar_fast(barcnt, (unsigned)(k) * (unsigned)G); } } while (0)

    if (IN(0)) {
        LAS float* scr = (LAS float*)(lds + wave * 16384);
        const int gw = bx * NWAVES + wave, NGW = G * NWAVES;
        constexpr int I_QK = 16 * (NQK / 32), I_V = 16 * (NV / 32), I_O = 16 * (DM / 32), I_GU = 16 * (NGU / 32), I_D = (FF / 64) * (DM / 32);
        constexpr int NITEMS = I_QK + I_V + I_O + I_GU + I_D;
        for (int it = gw; it < NITEMS; it += NGW) {
            int r = it;
            if (r < I_QK) { const int nb = r % (NQK / 32), kb = r / (NQK / 32); const int n0 = 32 * nb;
                const int pn = n0 >> 8, bj = (n0 >> 7) & 1, wc = (n0 >> 5) & 3; const int qc = 256 * pn + 64 * wc + 32 * bj; const int src = qc < 1024 ? qc : 1536 + (qc - 1024);
                p0_transpose_item(a.w_in, 3072, DM, src, 64 * kb, a.attn_g, Wqk_t, n0, scr, lane); continue; } r -= I_QK;
            if (r < I_V) { const int nb = r % (NV / 32), kb = r / (NV / 32); const int n0 = 32 * nb; const int src = n0 < 512 ? 1024 + n0 : 2560 + (n0 - 512);
                p0_transpose_item(a.w_in, 3072, DM, src, 64 * kb, a.attn_g, Wv_t, n0, scr, lane); continue; } r -= I_V;
            if (r < I_O) { const int nb = r % (DM / 32), kb = r / (DM / 32);
                p0_transpose_item(a.w_o, DM, DM, 32 * nb, 64 * kb, nullptr, Wo_t, 32 * nb, scr, lane); continue; } r -= I_O;
            if (r < I_GU) { const int nb = r % (NGU / 32), kb = r / (NGU / 32); const int n0 = 32 * nb; const int pn = n0 >> 8, bj = (n0 >> 7) & 1, dd = n0 & 127;
                p0_transpose_item(bj ? a.w_up : a.w_gate, FF, DM, 128 * pn + dd, 64 * kb, a.ffn_g, Wgu_t, n0, scr, lane); continue; } r -= I_GU;
            { const int nb = r % (DM / 32), kb = r / (DM / 32);
                p0_transpose_item(a.w_down, DM, FF, 32 * nb, 64 * kb, nullptr, Wd_t, 32 * nb, scr, lane); }
        }
        for (int m = gw; m < MTOK; m += NGW) {
            const f32x4* xr = (const f32x4*)(a.x + (size_t)m * DM) + lane; f32x4 v[4]; float s = 0.f;
#pragma unroll
            for (int j = 0; j < 4; ++j) { v[j] = __builtin_nontemporal_load(xr + 64 * j); s += (v[j][0] * v[j][0] + v[j][1] * v[j][1]) + (v[j][2] * v[j][2] + v[j][3] * v[j][3]); }
            s = wave_sum(s);
            u32x2* o8 = (u32x2*)(XB + (size_t)m * DM) + lane;
#pragma unroll
            for (int j = 0; j < 4; ++j) { u32x2 w; w.x = pg8::cvt_pk_bf16(v[j][0], v[j][1]); w.y = pg8::cvt_pk_bf16(v[j][2], v[j][3]); o8[64 * j] = w; }
            if (lane == 0) rstd1[m] = 1.0f / sqrtf(s * (1.0f / DM) + 1e-6f);
        }
        if (bx == 0 && tid == 0) __hip_atomic_store(barcnt, 0u, __ATOMIC_RELAXED, __HIP_MEMORY_SCOPE_AGENT);
        const int gt = bx * (NWAVES * 64) + tid, NGT = G * NWAVES * 64;
        for (int i = gt; i < MTOK; i += NGT) ss2[i] = 0.f;
        for (int i = gt; i < SEQ * 32; i += NGT) { const int pos = i >> 5, fi = i & 31;
            const float inv_freq = exp2f(-(float)fi * (13.287712379549449f / 32.0f));
            const float ang = (float)pos * inv_freq; ropec[i] = cosf(ang); ropes[i] = sinf(ang); }
    }
    SEAM(0);

    if (IN(1)) {
        { pg8::Gemm g{XB, Wqk_t, MTOK, NQK, DM}; pg8::StaticOrder S; S.init(MTOK, NQK, G, bx);
          pg8::EpiQK E{QKb, rstd1, a.gq, a.gk, ropec, ropes};
          pg8::gemm_phase<pg8::EpiQK, pg8::StaticOrder, true, true>(lds, g, S, E); }
        { pg8::Gemm g{Wv_t, XB, NV, MTOK, DM}; pg8::StaticOrder S; S.init(NV, MTOK, G, bx);
          pg8::EpiVt E{Vt, rstd1};
          pg8::gemm_phase<pg8::EpiVt, pg8::StaticOrder, true, true>(lds, g, S, E); }
    }
    SEAM(1);

    if (IN(2)) {
        for (int job = bx; job < BATCH * 8; job += G) {
            const int b = job >> 3, h = job & 7;
            att::sb_job(lds, QKb, Vt, MIX, b, h);
        }
        float lam;
        { const float p1 = a.lq1[lane] * a.lk1[lane], p2 = a.lq2[lane] * a.lk2[lane]; lam = expf(wave_sum(p1)) - expf(wave_sum(p2)) + 0.2f; }
        {
            const bool xm = (G == 256); const int xcd = bx & 7, ci = bx >> 3, cj = ci & 7;
            const int nun = xm ? 8 : (BATCH * 4 * 16 - bx + G - 1) / G;
            for (int u = 0; u < nun; ++u) {
                int bh, qb;
                if (xm) { bh = xcd * 16 + (u >> 1) * 4 + (ci >> 3); qb = (u & 1) ? 15 - cj : cj; } else { const int idx = bx + u * G; bh = idx >> 4; qb = idx & 15; }
                att::diff_unit(lds, QKb, Vt, MIX, a.gsub, lam, bh >> 2, bh & 3, qb);
            }
        }
    }
    SEAM(2);

    if (IN(3)) {
        pg8::Gemm g{MIX, Wo_t, MTOK, DM, DM}; pg8::StaticOrder S; S.init(MTOK, DM, G, bx);
        pg8::EpiWo E{a.x, XB, ss2};
        pg8::gemm_phase<pg8::EpiWo, pg8::StaticOrder, true, true>(lds, g, S, E);
    }
    SEAM(3);

    if (IN(4)) {
        pg8::Gemm g{XB, Wgu_t, MTOK, NGU, DM}; pg8::StaticOrder S; S.init(MTOK, NGU, G, bx);
        pg8::EpiGU E{HB, ss2};
        pg8::gemm_phase<pg8::EpiGU, pg8::StaticOrder, true, true>(lds, g, S, E);
    }
    SEAM(4);

    if (IN(5)) {
        pg8::Gemm g{HB, Wd_t, MTOK, DM, FF}; pg8::StaticOrder S; S.init(MTOK, DM, G, bx);
        pg8::EpiDown E{a.out, XB};
        pg8::gemm_phase<pg8::EpiDown, pg8::StaticOrder, true, true>(lds, g, S, E);
    }
#undef IN
#undef SEAM
}

extern "C" void kernel_launch(void* const* d_in, const int* in_sizes, int n_in, void* d_out, int out_size, void* d_ws, size_t ws_size, hipStream_t stream) {
    static int grid = 0;
    if (grid == 0) {
        if (n_in != 15 || in_sizes[0] != MTOK * DM || out_size != MTOK * DM || ws_size < WS_END) { fprintf(stderr, "kernel_launch: unexpected shapes/workspace (n_in %d, ws %zu)\n", n_in, ws_size); grid = -1; return; }
        int dev = 0, cus = 0, per_cu = 0;
        (void)hipGetDevice(&dev); (void)hipDeviceGetAttribute(&cus, hipDeviceAttributeMultiprocessorCount, dev);
        if (hipFuncSetAttribute((const void*)fwd_megakernel, hipFuncAttributeMaxDynamicSharedMemorySize, LDS_BYTES) != hipSuccess) { fprintf(stderr, "kernel_launch: hipFuncSetAttribute failed\n"); grid = -1; return; }
        if (hipOccupancyMaxActiveBlocksPerMultiprocessor(&per_cu, (const void*)fwd_megakernel, NWAVES * 64, LDS_BYTES) != hipSuccess || per_cu < 1) { fprintf(stderr, "kernel_launch: occupancy query gave %d\n", per_cu); per_cu = 1; }
        (void)hipGetLastError();
        grid = cus * per_cu;
    }
    if (grid < 0) return;
    Args a{};
    a.x = (const float*)d_in[0]; a.attn_g = (const float*)d_in[1]; a.w_in = (const float*)d_in[2]; a.gq = (const float*)d_in[3]; a.gk = (const float*)d_in[4];
    a.lq1 = (const float*)d_in[5]; a.lk1 = (const float*)d_in[6]; a.lq2 = (const float*)d_in[7]; a.lk2 = (const float*)d_in[8]; a.gsub = (const float*)d_in[9];
    a.w_o = (const float*)d_in[10]; a.ffn_g = (const float*)d_in[11]; a.w_gate = (const float*)d_in[12]; a.w_up = (const float*)d_in[13]; a.w_down = (const float*)d_in[14];
    a.out = (float*)d_out; a.ws = (unsigned char*)d_ws;
#if MK_LAUNCHES == 1
    a.ph_lo = 0; a.ph_hi = 6;
    void* args[] = {&a};
    hipError_t e = hipLaunchCooperativeKernel((const void*)fwd_megakernel, dim3(grid), dim3(NWAVES * 64), args, LDS_BYTES, stream);
    if (e != hipSuccess) fprintf(stderr, "cooperative launch failed: %s (grid %d)\n", hipGetErrorString(e), grid);
#else
    for (int p = 0; p < 6; ++p) { a.ph_lo = p; a.ph_hi = p + 1; hipLaunchKernelGGL(fwd_megakernel, dim3(grid), dim3(NWAVES * 64), LDS_BYTES, stream, a); }
#endif
}
```

```cpp
#include <hip/hip_runtime.h>
#include <hip/hip_cooperative_groups.h>
#include <cstdio>
#include <cstdint>
namespace cg = cooperative_groups;
namespace pg8 {
#define PG8_LAS __attribute__((address_space(3)))
typedef unsigned short bf16_t;
typedef short bf16x8 __attribute__((ext_vector_type(8)));
typedef float f32x4 __attribute__((ext_vector_type(4)));
typedef unsigned u32x4 __attribute__((ext_vector_type(4)));
constexpr int BM = 256, BK = 64, HALF = 128, HTB = HALF * BK * 2  , STAGE_BYTES = 8 * HTB, NXCD = 8, WGM = 8;

__host__ __device__ __forceinline__ int lds_byte(int r, int c) { const int st = (r >> 4) * 2 + (c >> 5), rr = r & 15, cc = c & 31, ob = rr * 64 + cc * 2; return st * 1024 + (ob ^ (((ob >> 9) & 1) << 5)); }
__host__ __device__ __forceinline__ void stage_rc(int b, int& R, int& C) { const int st = b / 1024, sb = b % 1024, swz = sb ^ (((sb >> 9) & 1) << 5); R = (st >> 1) * 16 + swz / 64; C = (st & 1) * 32 + (swz % 64) / 2; }
__host__ __device__ __forceinline__ int perm32(int rho) { const int n = rho >> 4, i = rho & 15; return 8 * (i >> 2) + 4 * n + (i & 3); }

struct Unit { int pm, pn; };
struct Gemm { const bf16_t* A; const bf16_t* Bt; int M, N, K; };

struct StaticOrder {
    int nM, nN, nwg, G, c;
    __host__ __device__ void init(int M, int N, int G_, int c_) { nM = M / BM; nN = N / BM; nwg = nM * nN; G = G_; c = c_; }
    __host__ __device__ bool next(int i, Unit& u) const {
        const long L = (long)i * G + c; if (L >= nwg) return false;
        int wgid = (int)L; { const int q = nwg / NXCD, r = nwg % NXCD, xcd = wgid % NXCD, off = wgid / NXCD; wgid = (xcd < r ? xcd * (q + 1) : r * (q + 1) + (xcd - r) * q) + off; }
        const int nig = WGM * nN, gid = wgid / nig, fm = gid * WGM, gsz = (nM - fm) < WGM ? (nM - fm) : WGM;
        u.pm = fm + ((wgid % nig) % gsz); u.pn = (wgid % nig) / gsz; return true;
    }
    __device__ __forceinline__ void a_ready(const Unit&) const {}
    __device__ __forceinline__ void done(const Unit&) const {}
};

typedef float f32x2_cv __attribute__((ext_vector_type(2))); typedef __bf16 bf16x2_cv __attribute__((ext_vector_type(2)));
__device__ __forceinline__ unsigned cvt_pk_bf16(float lo, float hi) { f32x2_cv v = {lo, hi}; bf16x2_cv b = __builtin_convertvector(v, bf16x2_cv); return __builtin_bit_cast(unsigned, b); }
__device__ __forceinline__ u32x4 pack8(const f32x4 a, const f32x4 b) { u32x4 w; w.x = cvt_pk_bf16(a[0], a[1]); w.y = cvt_pk_bf16(a[2], a[3]); w.z = cvt_pk_bf16(b[0], b[1]); w.w = cvt_pk_bf16(b[2], b[3]); return w; }

struct EpiQK {
    static constexpr bool PERM = true, AFTER_DRAIN = false;
    bf16_t* O; const float* rstd; const float* gq; const float* gk; const float* rc; const float* rs;
    __device__ __forceinline__ void operator()(const f32x4 (&acc)[2][2][4][2], const Unit& u, int wr, int wc, int fr, int fq) const {
        const int pn = u.pn; const bool is_diff = pn >= 4;
        const float qscale = (pn < 2) ? 0.125f * 1.4426950408889634f : 1.0f;
        const float* g = (pn >= 6) ? gk : gq;
        const int col0 = pn * 256 + wc * 64 + 8 * fq;
        f32x4 g1a = {1.f, 1.f, 1.f, 1.f}, g1b = g1a, g2a = g1a, g2b = g1a;
        if (is_diff) { g1a = *(const f32x4*)(g + 8 * fq); g1b = *(const f32x4*)(g + 8 * fq + 4); g2a = *(const f32x4*)(g + 32 + 8 * fq); g2b = *(const f32x4*)(g + 32 + 8 * fq + 4); }
        float rs8[8];
#pragma unroll
        for (int it = 0; it < 8; ++it) rs8[it] = rstd[u.pm * BM + (it >> 2) * HALF + wr * 64 + (it & 3) * 16 + fr];
        f32x4 cs[4];
#define QK_LOAD(IT) { const int pos_ = (u.pm * BM + ((IT) >> 2) * HALF + wr * 64 + ((IT) & 3) * 16 + fr) & 2047; \
            cs[0] = *(const f32x4*)(rc + pos_ * 32 + 8 * fq); cs[1] = *(const f32x4*)(rc + pos_ * 32 + 8 * fq + 4); cs[2] = *(const f32x4*)(rs + pos_ * 32 + 8 * fq); cs[3] = *(const f32x4*)(rs + pos_ * 32 + 8 * fq + 4); }
        if (is_diff) QK_LOAD(0);
#pragma unroll
        for (int ai = 0; ai < 2; ++ai)
#pragma unroll
            for (int m = 0; m < 4; ++m) {
                const int row = u.pm * BM + ai * HALF + wr * 64 + m * 16 + fr;
                const float rsd = rs8[ai * 4 + m] * qscale;
                f32x4 a0 = acc[ai][0][m][0] * rsd, a1 = acc[ai][0][m][1] * rsd, b0 = acc[ai][1][m][0] * rsd, b1 = acc[ai][1][m][1] * rsd;
                if (is_diff) {
                    float ss = (a0[0] * a0[0] + a0[1] * a0[1]) + (a0[2] * a0[2] + a0[3] * a0[3]);
                    ss += (a1[0] * a1[0] + a1[1] * a1[1]) + (a1[2] * a1[2] + a1[3] * a1[3]);
                    ss += (b0[0] * b0[0] + b0[1] * b0[1]) + (b0[2] * b0[2] + b0[3] * b0[3]);
                    ss += (b1[0] * b1[0] + b1[1] * b1[1]) + (b1[2] * b1[2] + b1[3] * b1[3]);
                    ss += __shfl_xor(ss, 16); ss += __shfl_xor(ss, 32);
                    const float rn = __builtin_amdgcn_rsqf(ss * (1.0f / 64.0f) + 1e-6f);
                    a0 = a0 * rn * g1a; a1 = a1 * rn * g1b; b0 = b0 * rn * g2a; b1 = b1 * rn * g2b;
                    const f32x4 c0 = cs[0], c1 = cs[1], s0 = cs[2], s1 = cs[3];
                    const f32x4 na0 = a0 * c0 - b0 * s0, nb0 = a0 * s0 + b0 * c0, na1 = a1 * c1 - b1 * s1, nb1 = a1 * s1 + b1 * c1;
                    a0 = na0; a1 = na1; b0 = nb0; b1 = nb1;
                }
                bf16_t* rowp = O + (size_t)row * 2048 + col0;
                const u32x4 wa = pack8(a0, a1), wb = pack8(b0, b1);
                if (is_diff && ai * 4 + m + 1 < 8) QK_LOAD(ai * 4 + m + 1);
                __builtin_nontemporal_store(wa, (u32x4*)(rowp));
                __builtin_nontemporal_store(wb, (u32x4*)(rowp + 32));
            }
#undef QK_LOAD
    }
};
struct EpiVt {
    static constexpr bool PERM = true, AFTER_DRAIN = false;
    bf16_t* O; const float* rstd;
    __device__ __forceinline__ void operator()(const f32x4 (&acc)[2][2][4][2], const Unit& u, int wr, int wc, int fr, int fq) const {
        const int ch0 = u.pm * BM + wr * 64 + fr; const int col0 = u.pn * BM + wc * 32 + 8 * fq;
        const bool dif = u.pm >= 2;
        f32x4 sc[2][2];
#pragma unroll
        for (int bj = 0; bj < 2; ++bj)
#pragma unroll
            for (int n = 0; n < 2; ++n) sc[bj][n] = *(const f32x4*)(rstd + col0 + bj * HALF + 4 * n);
#pragma unroll
        for (int ai = 0; ai < 2; ++ai)
#pragma unroll
            for (int m = 0; m < 4; ++m) { const int c = ch0 + ai * HALF + m * 16;
#pragma unroll
                for (int bj = 0; bj < 2; ++bj) { const int tok = col0 + bj * HALF; const int bt = tok >> 6, kv = tok & 63;
                    const size_t off = dif ? (size_t)512 * 65536 + ((size_t)(bt * 4 + ((c - 512) >> 7)) * 128 + ((c - 512) & 127)) * 64 + kv
                                           : ((size_t)(bt * 8 + (c >> 6)) * 64 + (c & 63)) * 64 + kv;
                    *(u32x4*)(O + off) = pack8(acc[ai][bj][m][0] * sc[bj][0], acc[ai][bj][m][1] * sc[bj][1]); } }
    }
};
struct EpiWo {
    static constexpr bool PERM = true, AFTER_DRAIN = false;
    const float* x; bf16_t* xb; float* ss2;
    __device__ __forceinline__ void operator()(const f32x4 (&acc)[2][2][4][2], const Unit& u, int wr, int wc, int fr, int fq) const {
        const int col0 = u.pn * BM + wc * 32 + 8 * fq;
        f32x4 xv[4];
#define WO_LOAD(IT) { const size_t off_ = (size_t)(u.pm * BM + ((IT) >> 2) * HALF + wr * 64 + ((IT) & 3) * 16 + fr) * 1024 + col0; \
            xv[0] = __builtin_nontemporal_load((const f32x4*)(x + off_)); xv[1] = __builtin_nontemporal_load((const f32x4*)(x + off_ + 4)); xv[2] = __builtin_nontemporal_load((const f32x4*)(x + off_ + HALF)); xv[3] = __builtin_nontemporal_load((const f32x4*)(x + off_ + HALF + 4)); }
        WO_LOAD(0);
#pragma unroll
        for (int it = 0; it < 8; ++it) {
            const int ai = it >> 2, m = it & 3;
            const int row = u.pm * BM + ai * HALF + wr * 64 + m * 16 + fr; const size_t off = (size_t)row * 1024 + col0; float ss = 0.f;
            u32x4 wq[2];
#pragma unroll
            for (int bj = 0; bj < 2; ++bj) {
                const f32x4 v0 = xv[2 * bj] + acc[ai][bj][m][0], v1 = xv[2 * bj + 1] + acc[ai][bj][m][1];
                ss += ((v0[0] * v0[0] + v0[1] * v0[1]) + (v0[2] * v0[2] + v0[3] * v0[3])) + ((v1[0] * v1[0] + v1[1] * v1[1]) + (v1[2] * v1[2] + v1[3] * v1[3]));
                wq[bj] = pack8(v0, v1); }
            ss += __shfl_xor(ss, 16); ss += __shfl_xor(ss, 32);
            if (it + 1 < 8) WO_LOAD(it + 1);
            *(u32x4*)(xb + off) = wq[0]; *(u32x4*)(xb + off + HALF) = wq[1];
            if (fq == 0) atomicAdd(ss2 + row, ss);
        }
#undef WO_LOAD
    }
};
struct EpiGU {
    static constexpr bool PERM = true, AFTER_DRAIN = false;
    bf16_t* H; const float* ss2;
    __device__ __forceinline__ void operator()(const f32x4 (&acc)[2][2][4][2], const Unit& u, int wr, int wc, int fr, int fq) const {
        const int col0 = u.pn * 128 + wc * 32 + 8 * fq;
        float sq[8];
#pragma unroll
        for (int it = 0; it < 8; ++it) sq[it] = ss2[u.pm * BM + (it >> 2) * HALF + wr * 64 + (it & 3) * 16 + fr];
#pragma unroll
        for (int ai = 0; ai < 2; ++ai)
#pragma unroll
            for (int m = 0; m < 4; ++m) {
                const int row = u.pm * BM + ai * HALF + wr * 64 + m * 16 + fr;
                const float rsd = __builtin_amdgcn_rsqf(sq[ai * 4 + m] * (1.0f / 1024.0f) + 1e-6f);
                const float ka = -1.4426950408889634f * rsd, r2 = rsd * rsd;
                f32x4 hv[2];
#pragma unroll
                for (int n = 0; n < 2; ++n) { const f32x4 ag = acc[ai][0][m][n], au = acc[ai][1][m][n];
                    const f32x4 ea = ag * ka; f32x4 ex;
#pragma unroll
                    for (int j = 0; j < 4; ++j) ex[j] = __builtin_amdgcn_exp2f(ea[j]);
                    const f32x4 den = ex + 1.0f; f32x4 rc;
#pragma unroll
                    for (int j = 0; j < 4; ++j) rc[j] = __builtin_amdgcn_rcpf(den[j]);
                    hv[n] = ((ag * au) * r2) * rc; }
                __builtin_nontemporal_store(pack8(hv[0], hv[1]), (u32x4*)(H + (size_t)row * 2816 + col0));
            }
    }
};
struct EpiDown {
    static constexpr bool PERM = false, AFTER_DRAIN = false;
    float* out; const bf16_t* xb;
    __device__ __forceinline__ void operator()(const f32x4 (&acc)[2][2][4][2], const Unit& u, int wr, int wc, int fr, int fq) const {
        typedef unsigned u32x2v __attribute__((ext_vector_type(2)));
        const int col0 = u.pn * BM + wc * 32 + 4 * fq;
        u32x2v xw[4];
#define DN_LOAD(IT) { const size_t off_ = (size_t)(u.pm * BM + ((IT) >> 2) * HALF + wr * 64 + ((IT) & 3) * 16 + fr) * 1024 + col0; \
            xw[0] = *(const u32x2v*)(xb + off_); xw[1] = *(const u32x2v*)(xb + off_ + 16); xw[2] = *(const u32x2v*)(xb + off_ + HALF); xw[3] = *(const u32x2v*)(xb + off_ + HALF + 16); }
        DN_LOAD(0);
#pragma unroll
        for (int it = 0; it < 8; ++it) {
            const int ai = it >> 2, m = it & 3;
            const size_t off = (size_t)(u.pm * BM + ai * HALF + wr * 64 + m * 16 + fr) * 1024 + col0;
            f32x4 rv[4];
#pragma unroll
            for (int q = 0; q < 4; ++q) { const u32x2v w = xw[q];
                f32x4 r; r[0] = __uint_as_float(w.x << 16); r[1] = __uint_as_float(w.x & 0xffff0000u); r[2] = __uint_as_float(w.y << 16); r[3] = __uint_as_float(w.y & 0xffff0000u);
                rv[q] = r + acc[ai][q >> 1][m][q & 1]; }
            if (it + 1 < 8) DN_LOAD(it + 1);
#pragma unroll
            for (int q = 0; q < 4; ++q) __builtin_nontemporal_store(rv[q], (f32x4*)(out + off + (q >> 1) * HALF + (q & 1) * 16));
        }
#undef DN_LOAD
    }
};

template <class Epi, class Sched, bool ALIGN_EPI = false, bool SP2 = false>
__device__ __forceinline__ void gemm_phase(PG8_LAS unsigned char* lds, const Gemm g, const Sched& S, const Epi& E) {
    const int tid = threadIdx.x, wid = __builtin_amdgcn_readfirstlane(tid >> 6), lane = tid & 63, wr = wid >> 2, wc = wid & 3, fr = lane & 15, fq = lane >> 4;
    const int K = g.K, nt = K / BK;
    unsigned voffA[2], voffB[2];
#pragma unroll
    for (int i = 0; i < 2; ++i) { int R, C; stage_rc(tid * 16 + i * 8192, R, C); const int Rb = Epi::PERM ? ((R & ~31) + perm32(R & 31)) : R;
        voffA[i] = (unsigned)(R * K + C) * 2u; voffB[i] = (unsigned)(Rb * K + C) * 2u; }
    const size_t kstep = (size_t)(BK * 2);
    const size_t hstep = (size_t)HALF * K * 2;
    const size_t tstep = 2 * hstep;
    const unsigned ldsw = (unsigned)wid * 1024u;
    const int aoff = lds_byte(wr * 64 + fr, fq * 8), boff = lds_byte(wc * 32 + fr, fq * 8);
#define PG8_SA(b, h) (((b) * 2 + (h)) * HTB)
#define PG8_SB(b, h) ((4 + (b) * 2 + (h)) * HTB)
#define PG8_STAGE(bufoff, gbase, voff) do { _Pragma("unroll") for (int _i = 0; _i < 2; ++_i) \
        __builtin_amdgcn_global_load_lds((const unsigned*)((const char*)(gbase) + (voff)[_i]), (PG8_LAS unsigned*)(lds + (bufoff) + ldsw + _i * 8192), 16, 0, 0); } while (0)
#define PG8_LDA(dst, b, h) do { _Pragma("unroll") for (int m = 0; m < 4; ++m) _Pragma("unroll") for (int k = 0; k < 2; ++k) dst[m][k] = *(const PG8_LAS bf16x8*)(lds + PG8_SA(b, h) + aoff + m * 2048 + k * 1024); } while (0)
#define PG8_LDB(dst, b, h) do { _Pragma("unroll") for (int n = 0; n < 2; ++n) _Pragma("unroll") for (int k = 0; k < 2; ++k) dst[n][k] = *(const PG8_LAS bf16x8*)(lds + PG8_SB(b, h) + boff + n * 2048 + k * 1024); } while (0)
#define PG8_MMA(ai, bj, At, Bt) do { __builtin_amdgcn_s_setprio(1); _Pragma("unroll") for (int m = 0; m < 4; ++m) _Pragma("unroll") for (int n = 0; n < 2; ++n) _Pragma("unroll") for (int k = 0; k < 2; ++k) \
        acc[ai][bj][m][n] = __builtin_amdgcn_mfma_f32_16x16x32_bf16(Bt[n][k], At[m][k], acc[ai][bj][m][n], 0, 0, 0); __builtin_amdgcn_s_setprio(0); } while (0)
#define PG8_WAIT_V(n) asm volatile("s_waitcnt vmcnt(" #n ")" ::: "memory")
#define PG8_WAIT_L(n) asm volatile("s_waitcnt lgkmcnt(" #n ")" ::: "memory")
#define PG8_BAR __builtin_amdgcn_s_barrier()
#define PG8_SCHED __builtin_amdgcn_sched_barrier(0)
    Unit cur, nxt; int ui = 0;
    if (!S.next(0, cur)) return;
    f32x4 acc[2][2][4][2];
#pragma unroll
    for (int a = 0; a < 2; ++a)
#pragma unroll
        for (int b = 0; b < 2; ++b)
#pragma unroll
            for (int m = 0; m < 4; ++m)
#pragma unroll
                for (int n = 0; n < 2; ++n) acc[a][b][m][n] = (f32x4){0.f, 0.f, 0.f, 0.f};
    bf16x8 At[4][2], B0[2][2], B1[2][2];
    const char* cA = (const char*)g.A + (size_t)cur.pm * tstep; const char* cB = (const char*)g.Bt + (size_t)cur.pn * tstep;
    S.a_ready(cur);
    if constexpr (SP2) {
        PG8_STAGE(PG8_SB(0, 0), cB, voffB); PG8_STAGE(PG8_SB(0, 1), cB + hstep, voffB); PG8_STAGE(PG8_SA(0, 0), cA, voffA); PG8_STAGE(PG8_SA(0, 1), cA + hstep, voffA);
        if (wr == 1) PG8_BAR;
        PG8_WAIT_V(2); PG8_BAR;
        PG8_STAGE(PG8_SB(1, 0), cB + kstep, voffB); PG8_STAGE(PG8_SA(1, 0), cA + kstep, voffA); PG8_STAGE(PG8_SB(1, 1), cB + hstep + kstep, voffB);
        PG8_WAIT_V(6); PG8_BAR;
    } else {
        PG8_STAGE(PG8_SB(0, 0), cB, voffB); PG8_STAGE(PG8_SA(0, 0), cA, voffA); PG8_STAGE(PG8_SB(0, 1), cB + hstep, voffB); PG8_STAGE(PG8_SA(0, 1), cA + hstep, voffA);
        if (wr == 1) PG8_BAR;
        PG8_WAIT_V(4); PG8_BAR;
        PG8_STAGE(PG8_SB(1, 0), cB + kstep, voffB); PG8_STAGE(PG8_SA(1, 0), cA + kstep, voffA); PG8_STAGE(PG8_SB(1, 1), cB + hstep + kstep, voffB);
        PG8_WAIT_V(6); PG8_BAR;
    }
    for (;;) {
        const bool has_next = S.next(ui + 1, nxt);
        const char* nA = has_next ? (const char*)g.A + (size_t)nxt.pm * tstep : cA; const char* nB = has_next ? (const char*)g.Bt + (size_t)nxt.pn * tstep : cB;
        for (int t = 0; t < nt; t += 2) {
            const bool last = (t == nt - 2);
            const char* a1 = cA + (size_t)(t + 1) * kstep;
            const char* a2 = last ? nA : cA + (size_t)(t + 2) * kstep; const char* b2 = last ? nB : cB + (size_t)(t + 2) * kstep;
            const char* a3 = a2 + kstep; const char* b3 = b2 + kstep;
            if (last && has_next) S.a_ready(nxt);
            if constexpr (SP2) {
            PG8_LDB(B0, 0, 0); PG8_LDB(B1, 0, 1); PG8_SCHED; PG8_LDA(At, 0, 0); PG8_STAGE(PG8_SA(1, 1), a1 + hstep, voffA);
            PG8_WAIT_V(8); PG8_WAIT_L(0); PG8_BAR; PG8_MMA(0, 0, At, B0); PG8_MMA(0, 1, At, B1); PG8_BAR; PG8_SCHED;
            PG8_LDA(At, 0, 1); PG8_STAGE(PG8_SB(0, 0), b2, voffB); PG8_STAGE(PG8_SB(0, 1), b2 + hstep, voffB); PG8_STAGE(PG8_SA(0, 0), a2, voffA);
            PG8_WAIT_V(8); PG8_WAIT_L(0); PG8_BAR; PG8_MMA(1, 0, At, B0); PG8_MMA(1, 1, At, B1); PG8_BAR; PG8_SCHED;
            PG8_LDB(B0, 1, 0); PG8_LDB(B1, 1, 1); PG8_SCHED; PG8_LDA(At, 1, 0); PG8_STAGE(PG8_SA(0, 1), a2 + hstep, voffA);
            PG8_WAIT_V(8); PG8_WAIT_L(0); PG8_BAR; PG8_MMA(0, 0, At, B0); PG8_MMA(0, 1, At, B1); PG8_BAR; PG8_SCHED;
            PG8_LDA(At, 1, 1); PG8_STAGE(PG8_SB(1, 0), b3, voffB); PG8_STAGE(PG8_SB(1, 1), b3 + hstep, voffB); PG8_STAGE(PG8_SA(1, 0), a3, voffA);
            PG8_WAIT_V(8); PG8_WAIT_L(0); PG8_BAR; PG8_MMA(1, 0, At, B0); PG8_MMA(1, 1, At, B1); PG8_BAR; PG8_SCHED;
            } else {
            PG8_LDB(B0, 0, 0); PG8_SCHED; PG8_LDA(At, 0, 0); PG8_STAGE(PG8_SA(1, 1), a1 + hstep, voffA);
            PG8_WAIT_L(8); PG8_BAR; PG8_WAIT_L(0); PG8_MMA(0, 0, At, B0); PG8_BAR; PG8_SCHED;
            PG8_LDB(B1, 0, 1); PG8_STAGE(PG8_SB(0, 0), b2, voffB);
            PG8_BAR; PG8_WAIT_L(0); PG8_MMA(0, 1, At, B1); PG8_BAR;
            PG8_LDA(At, 0, 1); PG8_STAGE(PG8_SA(0, 0), a2, voffA);
            PG8_BAR; PG8_WAIT_L(0); PG8_MMA(1, 0, At, B0); PG8_BAR; PG8_SCHED;
            PG8_STAGE(PG8_SB(0, 1), b2 + hstep, voffB);
            PG8_WAIT_V(6); PG8_BAR; PG8_MMA(1, 1, At, B1); PG8_BAR;
            PG8_LDB(B0, 1, 0); PG8_SCHED; PG8_LDA(At, 1, 0); PG8_STAGE(PG8_SA(0, 1), a2 + hstep, voffA);
            PG8_WAIT_L(8); PG8_BAR; PG8_WAIT_L(0); PG8_MMA(0, 0, At, B0); PG8_BAR; PG8_SCHED;
            PG8_LDB(B1, 1, 1); PG8_STAGE(PG8_SB(1, 0), b3, voffB);
            PG8_BAR; PG8_WAIT_L(0); PG8_MMA(0, 1, At, B1); PG8_BAR;
            PG8_LDA(At, 1, 1); PG8_STAGE(PG8_SA(1, 0), a3, voffA);
            PG8_BAR; PG8_WAIT_L(0); PG8_MMA(1, 0, At, B0); PG8_BAR; PG8_SCHED;
            PG8_STAGE(PG8_SB(1, 1), b3 + hstep, voffB);
            PG8_WAIT_V(6); PG8_BAR; PG8_MMA(1, 1, At, B1); PG8_BAR;
            }
        }
        if constexpr (ALIGN_EPI) { if (wr == 0) PG8_BAR; }
        if constexpr (!Epi::AFTER_DRAIN) { E(acc, cur, wr, wc, fr, fq); S.done(cur); }
        if (!has_next) break;
#pragma unroll
        for (int a = 0; a < 2; ++a)
#pragma unroll
            for (int b = 0; b < 2; ++b)
#pragma unroll
                for (int m = 0; m < 4; ++m)
#pragma unroll
                    for (int n = 0; n < 2; ++n) acc[a][b][m][n] = (f32x4){0.f, 0.f, 0.f, 0.f};
        cur = nxt; cA = nA; cB = nB; ++ui;
        if constexpr (ALIGN_EPI) { if (wr == 1) PG8_BAR; }
    }
    PG8_WAIT_V(0);
    if constexpr (!ALIGN_EPI) { if (wr == 0) PG8_BAR; }
    PG8_BAR;
    if constexpr (Epi::AFTER_DRAIN) { E.fused(acc, cur, wr, wc, fr, fq, lds, wid, lane); S.done(cur); }
#undef PG8_SA
#undef PG8_SB
#undef PG8_STAGE
#undef PG8_LDA
#undef PG8_LDB
#undef PG8_MMA
#undef PG8_WAIT_V
#undef PG8_WAIT_L
#undef PG8_BAR
#undef PG8_SCHED
}
}

namespace att {
#define LAS __attribute__((address_space(3)))
typedef unsigned short bf16_t;
typedef short bf16x8 __attribute__((ext_vector_type(8)));
typedef float f32x16 __attribute__((ext_vector_type(16)));
typedef float f32x4 __attribute__((ext_vector_type(4)));
typedef unsigned u32x4 __attribute__((ext_vector_type(4)));
typedef unsigned u32x2 __attribute__((ext_vector_type(2)));
typedef float f32x2 __attribute__((ext_vector_type(2)));
constexpr int SEQ = 2048, MTOK = 65536, NQK = 2048, DMIX = 1024;
constexpr float C2 = 0.125f * 1.4426950408889634f;
#define MFMA32(a, b, c) __builtin_amdgcn_mfma_f32_32x32x16_bf16((a), (b), (c), 0, 0, 0)
__device__ __forceinline__ int crow(int r, int hi) { return (r & 3) + 8 * (r >> 2) + 4 * hi; }
__device__ __forceinline__ int swap23(int i) { return (i & 0x13) | ((i & 4) << 1) | ((i & 8) >> 1); }
typedef float f32x2_cv __attribute__((ext_vector_type(2))); typedef __bf16 bf16x2_cv __attribute__((ext_vector_type(2)));
__device__ __forceinline__ unsigned cvtpk(float lo, float hi) { f32x2_cv v = {lo, hi}; bf16x2_cv b = __builtin_convertvector(v, bf16x2_cv); return __builtin_bit_cast(unsigned, b); }
__device__ __forceinline__ void halves(float x, float& lo, float& up) { auto rr = __builtin_amdgcn_permlane32_swap(__float_as_uint(x), __float_as_uint(x), false, false); lo = __uint_as_float(rr[0]); up = __uint_as_float(rr[1]); }

constexpr int SB_ROW = 144, SB_SLOT = 2 * 9216, SB_NSLOT = 6, SB_FLAGS = SB_NSLOT * SB_SLOT, SB_VTILE = 8 * 64 * 64  ;
__device__ __forceinline__ void sb_tile(const LAS unsigned char* Sb, int kfo, int vfo, const bf16x8 (&qf)[4], f32x16& o0, f32x16& o1, float& R, bool diag, int t, int hi, int qrow) {
    f32x16 p0, p1;
#pragma unroll
    for (int r = 0; r < 16; ++r) { p0[r] = 0.f; p1[r] = 0.f; }
#pragma unroll
    for (int d0 = 0; d0 < 4; ++d0) {
        const bf16x8 a0 = *(const LAS bf16x8*)(Sb + kfo + d0 * 32), a1 = *(const LAS bf16x8*)(Sb + kfo + 32 * SB_ROW + d0 * 32);
        p0 = MFMA32(a0, qf[d0], p0); p1 = MFMA32(a1, qf[d0], p1);
    }
    float cc[32], bb[32];
#pragma unroll
    for (int i = 0; i < 32; ++i) {
        const int p = i >> 4, r = i & 15;
        const float s = __builtin_amdgcn_fmed3f(p ? p1[r] : p0[r], -126.0f, 126.0f);
        const float E = __builtin_amdgcn_exp2f(s);
        const float c1 = __builtin_amdgcn_rcpf(1.0f + E);
        cc[i] = c1;
        bb[i] = E * c1;
    }
    if (diag) {
        asm volatile("" ::: "memory");
        const int kvb = 64 * t + 8 * hi;
#pragma unroll
        for (int i = 0; i < 32; ++i) { const int kv = kvb + 32 * (i >> 4) + (i & 7) + 16 * ((i & 15) >> 3); if (kv >= qrow) { bb[i] = 0.f; cc[i] = 1.f; } }
    }
    float ex[32], T[4];
#pragma unroll
    for (int k = 0; k < 4; ++k) {
        ex[8 * k + 7] = 1.f;
#pragma unroll
        for (int i = 6; i >= 0; --i) ex[8 * k + i] = ex[8 * k + i + 1] * cc[8 * k + i + 1];
        T[k] = ex[8 * k] * cc[8 * k];
    }
    float tl[4], tu[4];
#pragma unroll
    for (int k = 0; k < 4; ++k) halves(T[k], tl[k], tu[k]);
    float offl[4], offu[4]; float run = R;
#pragma unroll
    for (int k = 3; k >= 0; --k) { offu[k] = run; run *= tu[k]; offl[k] = run; run *= tl[k]; }
    R = run;
    u32x4 pa[4];
#pragma unroll
    for (int k = 0; k < 4; ++k) {
        const float off = hi ? offu[k] : offl[k];
        float w[8];
#pragma unroll
        for (int i = 0; i < 8; ++i) w[i] = bb[8 * k + i] * (off * ex[8 * k + i]);
        pa[k].x = cvtpk(w[0], w[1]); pa[k].y = cvtpk(w[2], w[3]); pa[k].z = cvtpk(w[4], w[5]); pa[k].w = cvtpk(w[6], w[7]);
    }
#pragma unroll
    for (int m = 0; m < 4; ++m) {
        const bf16x8 v0 = *(const LAS bf16x8*)(Sb + vfo + m * 32), v1 = *(const LAS bf16x8*)(Sb + vfo + 32 * SB_ROW + m * 32);
        o0 = MFMA32(v0, __builtin_bit_cast(bf16x8, pa[m]), o0); o1 = MFMA32(v1, __builtin_bit_cast(bf16x8, pa[m]), o1);
    }
}
__device__ __forceinline__ void sb_job(LAS unsigned char* lds, const bf16_t* __restrict__ QK, const bf16_t* __restrict__ Vt, bf16_t* __restrict__ MIX, int b, int h) {
    const int tid = threadIdx.x, lane = tid & 63, r32 = lane & 31, hi = lane >> 5;
    const int wid = __builtin_amdgcn_readfirstlane(tid >> 6);
    const int tok0 = b * SEQ;
    const int srow = tid >> 3, sch = tid & 7;
    const bf16_t* kg = QK + (size_t)(tok0 + srow) * NQK + 512 + h * 64 + sch * 8;
    const bf16_t* vg = Vt + ((size_t)(b * 32 * 8 + h) * 64 + srow) * 64 + sch * 8;
    const bf16_t* Qb = QK + (size_t)(tok0 + wid * 32 + r32) * NQK + h * 64 + hi * 8;
    const int sdst = srow * SB_ROW + sch * 16;
    const int kfo = swap23(r32) * SB_ROW + hi * 16, vfo = 9216 + r32 * SB_ROW + hi * 16;
    LAS unsigned* flags = (LAS unsigned*)(lds + SB_FLAGS);
    bf16x8 qfn[4]; u32x4 kr[4], vr[4], kAn, vAn;
#define SB_PRELOAD(QB) { const int t0_ = 4 * (QB); \
        _Pragma("unroll") for (int d0 = 0; d0 < 4; ++d0) qfn[d0] = *(const bf16x8*)(Qb + (size_t)(QB) * 256 * NQK + 16 * d0); \
        _Pragma("unroll") for (int i = 0; i < 4; ++i) { kr[i] = *(const u32x4*)(kg + (size_t)(t0_ + i) * 64 * NQK); vr[i] = *(const u32x4*)(vg + (size_t)(t0_ + i) * SB_VTILE); } \
        if (t0_ >= 1) { kAn = *(const u32x4*)(kg + (size_t)(t0_ - 1) * 64 * NQK); vAn = *(const u32x4*)(vg + (size_t)(t0_ - 1) * SB_VTILE); } }
    SB_PRELOAD(0);
    for (int ui = 0; ui < 8; ++ui) {
    const int qb = (ui & 1) ? 7 - (ui >> 1) : (ui >> 1);
    const int qrow = qb * 256 + wid * 32 + r32;
    bf16x8 qf[4];
#pragma unroll
    for (int d0 = 0; d0 < 4; ++d0) qf[d0] = qfn[d0];
    const int T0 = 4 * qb, td = T0 + (wid >> 1);
    f32x16 o0, o1;
#pragma unroll
    for (int r = 0; r < 16; ++r) { o0[r] = 0.f; o1[r] = 0.f; }
    float R = 1.f;
    const int s0 = T0 % SB_NSLOT;
    u32x4 kA = kAn, vA = vAn, kB, vB;
#pragma unroll
    for (int i = 0; i < 4; ++i) { int sl = s0 + i; sl = sl >= SB_NSLOT ? sl - SB_NSLOT : sl; *(LAS u32x4*)(lds + sl * SB_SLOT + sdst) = kr[i]; *(LAS u32x4*)(lds + sl * SB_SLOT + 9216 + sdst) = vr[i]; }
    __syncthreads();
    int myslot = s0 + (wid >> 1); myslot = myslot >= SB_NSLOT ? myslot - SB_NSLOT : myslot;
    int pslot = s0 == 0 ? SB_NSLOT - 1 : s0 - 1;
    bool wdone = false, alld = false;
#define SB_STEP(J, KW, VW, KL, VL) { \
        const int t_ = td - (J), tw_ = T0 - (J) - 1, tl_ = T0 - (J) - 2; \
        if (tl_ >= 0) { KL = *(const u32x4*)(kg + (size_t)tl_ * 64 * NQK); VL = *(const u32x4*)(vg + (size_t)tl_ * SB_VTILE); } \
        if (t_ >= 0 && !wdone) { sb_tile(lds + myslot * SB_SLOT, kfo, vfo, qf, o0, o1, R, (J) == 0, t_, hi, qrow); wdone = __all(R == 0.0f);   } \
        const bool fin_ = wdone || (t_ <= 0); \
        if (lane == 0) flags[((J) & 1) * 8 + wid] = fin_ ? 1u : 0u; \
        if (tw_ >= 0) { *(LAS u32x4*)(lds + pslot * SB_SLOT + sdst) = KW; *(LAS u32x4*)(lds + pslot * SB_SLOT + 9216 + sdst) = VW; } \
        __syncthreads(); \
        alld = __all(flags[((J) & 1) * 8 + (lane & 7)] != 0u); \
        myslot = myslot == 0 ? SB_NSLOT - 1 : myslot - 1; pslot = pslot == 0 ? SB_NSLOT - 1 : pslot - 1; }
    for (int j = 0;; j += 2) {
        SB_STEP(j, kA, vA, kB, vB);
        if (alld) break;
        SB_STEP(j + 1, kB, vB, kA, vA);
        if (alld) break;
    }
#undef SB_STEP
    if (ui + 1 < 8) { const int qn = ((ui + 1) & 1) ? 7 - ((ui + 1) >> 1) : ((ui + 1) >> 1); SB_PRELOAD(qn); }
    LAS unsigned char* stg = lds + wid * (32 * 144);
#pragma unroll
    for (int g4 = 0; g4 < 4; ++g4) {
        u32x2 w0, w1; w0.x = cvtpk(o0[4 * g4], o0[4 * g4 + 1]); w0.y = cvtpk(o0[4 * g4 + 2], o0[4 * g4 + 3]); w1.x = cvtpk(o1[4 * g4], o1[4 * g4 + 1]); w1.y = cvtpk(o1[4 * g4 + 2], o1[4 * g4 + 3]);
        *(LAS u32x2*)(stg + r32 * 144 + (8 * g4 + 4 * hi) * 2) = w0; *(LAS u32x2*)(stg + r32 * 144 + 64 + (8 * g4 + 4 * hi) * 2) = w1;
    }
    asm volatile("s_waitcnt lgkmcnt(0)" ::: "memory");
    bf16_t* Ow = MIX + (size_t)(tok0 + qb * 256 + wid * 32) * DMIX + h * 64;
#pragma unroll
    for (int i = 0; i < 4; ++i) { const int row = 8 * i + (lane >> 3), ch = lane & 7;
        const u32x4 v = *(const LAS u32x4*)(stg + row * 144 + ch * 16);
        __builtin_nontemporal_store(v, (u32x4*)(Ow + (size_t)row * DMIX + ch * 8)); }
    __syncthreads();
    }
#undef SB_PRELOAD
}

constexpr int DF_KROW = 272, DF_KBUF = 64 * 272, DF_VROW = 144, DF_VBUF = 128 * 144, DF_KS = 0, DF_VS = 2 * DF_KBUF;
__device__ __forceinline__ void diff_tile(const LAS unsigned char* Kb, const LAS unsigned char* Vb, int kfo, int vfo, const bf16x8 (&qf)[4], f32x16 (&o)[4], float& mrun, float& lsum, bool diag, int kvb, int qrow) {
#define SCHED_FENCE() __builtin_amdgcn_sched_barrier(0)
    bf16x8 kf[8];
#pragma unroll
    for (int d0 = 0; d0 < 4; ++d0) { kf[2 * d0] = *(const LAS bf16x8*)(Kb + kfo + d0 * 32); kf[2 * d0 + 1] = *(const LAS bf16x8*)(Kb + kfo + 32 * DF_KROW + d0 * 32); }
    SCHED_FENCE();
    f32x16 p0, p1;
#pragma unroll
    for (int r = 0; r < 16; ++r) { p0[r] = 0.f; p1[r] = 0.f; }
#pragma unroll
    for (int d0 = 0; d0 < 4; ++d0) { p0 = MFMA32(kf[2 * d0], qf[d0], p0); p1 = MFMA32(kf[2 * d0 + 1], qf[d0], p1); }
    SCHED_FENCE();
    if (diag) {
        asm volatile("" ::: "memory");
#pragma unroll
        for (int r = 0; r < 16; ++r) { const int kv = kvb + (r & 7) + 16 * (r >> 3); if (kv > qrow) p0[r] = -1e30f; if (kv + 32 > qrow) p1[r] = -1e30f; }
    }
    float rm = __builtin_fmaxf(p0[0], p1[0]);
#pragma unroll
    for (int r = 1; r < 16; ++r) rm = __builtin_fmaxf(__builtin_fmaxf(rm, p0[r]), p1[r]);
    { float lo, up; halves(rm, lo, up); rm = __builtin_fmaxf(lo, up) * C2; }
    if (__any(rm > mrun + 6.0f)) {
        const float mnew = __builtin_fmaxf(mrun, rm);
        const float alpha = __builtin_amdgcn_exp2f(mrun - mnew); lsum *= alpha;
#pragma unroll
        for (int d0 = 0; d0 < 4; ++d0)
#pragma unroll
            for (int r = 0; r < 16; ++r) o[d0][r] *= alpha;
        mrun = mnew;
    }
    u32x4 pa[4]; f32x2 ls2 = {0.f, 0.f}; const f32x2 c2v = {C2, C2}, nmv = {-mrun, -mrun};
    bf16x8 vf[16];
#define RDV(j) vf[j] = *(const LAS bf16x8*)(Vb + vfo + ((j) & 3) * 32 * DF_VROW + ((j) >> 2) * 32)
#define EXP_PAIR(P, R, DST) do { const f32x2 e_ = (f32x2){P[R], P[(R) + 1]} * c2v + nmv; const f32x2 w_ = (f32x2){__builtin_amdgcn_exp2f(e_[0]), __builtin_amdgcn_exp2f(e_[1])}; ls2 += w_; DST = cvtpk(w_[0], w_[1]); } while (0)
    SCHED_FENCE();
    RDV(0); RDV(1); EXP_PAIR(p0, 0, pa[0].x); EXP_PAIR(p0, 2, pa[0].y); EXP_PAIR(p0, 4, pa[0].z); EXP_PAIR(p0, 6, pa[0].w); SCHED_FENCE();
    RDV(2); o[0] = MFMA32(vf[0], __builtin_bit_cast(bf16x8, pa[0]), o[0]); EXP_PAIR(p0, 8, pa[1].x); SCHED_FENCE();
    RDV(3); o[1] = MFMA32(vf[1], __builtin_bit_cast(bf16x8, pa[0]), o[1]); EXP_PAIR(p0, 10, pa[1].y); SCHED_FENCE();
    RDV(4); o[2] = MFMA32(vf[2], __builtin_bit_cast(bf16x8, pa[0]), o[2]); EXP_PAIR(p0, 12, pa[1].z); SCHED_FENCE();
    RDV(5); o[3] = MFMA32(vf[3], __builtin_bit_cast(bf16x8, pa[0]), o[3]); EXP_PAIR(p0, 14, pa[1].w); SCHED_FENCE();
    RDV(6); o[0] = MFMA32(vf[4], __builtin_bit_cast(bf16x8, pa[1]), o[0]); EXP_PAIR(p1, 0, pa[2].x); SCHED_FENCE();
    RDV(7); o[1] = MFMA32(vf[5], __builtin_bit_cast(bf16x8, pa[1]), o[1]); EXP_PAIR(p1, 2, pa[2].y); SCHED_FENCE();
    RDV(8); o[2] = MFMA32(vf[6], __builtin_bit_cast(bf16x8, pa[1]), o[2]); EXP_PAIR(p1, 4, pa[2].z); SCHED_FENCE();
    RDV(9); o[3] = MFMA32(vf[7], __builtin_bit_cast(bf16x8, pa[1]), o[3]); EXP_PAIR(p1, 6, pa[2].w); SCHED_FENCE();
    RDV(10); o[0] = MFMA32(vf[8], __builtin_bit_cast(bf16x8, pa[2]), o[0]); EXP_PAIR(p1, 8, pa[3].x); SCHED_FENCE();
    RDV(11); o[1] = MFMA32(vf[9], __builtin_bit_cast(bf16x8, pa[2]), o[1]); EXP_PAIR(p1, 10, pa[3].y); SCHED_FENCE();
    RDV(12); o[2] = MFMA32(vf[10], __builtin_bit_cast(bf16x8, pa[2]), o[2]); EXP_PAIR(p1, 12, pa[3].z); SCHED_FENCE();
    RDV(13); o[3] = MFMA32(vf[11], __builtin_bit_cast(bf16x8, pa[2]), o[3]); EXP_PAIR(p1, 14, pa[3].w); SCHED_FENCE();
    RDV(14); o[0] = MFMA32(vf[12], __builtin_bit_cast(bf16x8, pa[3]), o[0]); SCHED_FENCE();
    RDV(15); o[1] = MFMA32(vf[13], __builtin_bit_cast(bf16x8, pa[3]), o[1]); SCHED_FENCE();
    o[2] = MFMA32(vf[14], __builtin_bit_cast(bf16x8, pa[3]), o[2]); SCHED_FENCE();
    o[3] = MFMA32(vf[15], __builtin_bit_cast(bf16x8, pa[3]), o[3]); SCHED_FENCE();
#undef EXP_PAIR
#undef RDV
    lsum += ls2[0] + ls2[1];
#undef SCHED_FENCE
}
__device__ __forceinline__ void diff_unit(LAS unsigned char* lds, const bf16_t* __restrict__ QK, const bf16_t* __restrict__ Vt, bf16_t* __restrict__ MIX, const float* __restrict__ gsub, float lam, int b, int h, int qb) {
    const int tid = threadIdx.x, lane = tid & 63, r32 = lane & 31, hi = lane >> 5;
    const int wid = __builtin_amdgcn_readfirstlane(tid >> 6);
    const int c = wid >> 2, g = wid & 3;
    const int tok0 = b * SEQ;
    const int qrow = qb * 128 + g * 32 + r32;
    const bf16_t* Qp = QK + (size_t)(tok0 + qrow) * NQK + 1024 + h * 128 + c * 64 + hi * 8;
    bf16x8 qf[4];
#pragma unroll
    for (int d0 = 0; d0 < 4; ++d0) qf[d0] = *(const bf16x8*)(Qp + 16 * d0);
    const int NT = 2 * qb + 2, td = 2 * qb + (g >> 1);
    const bf16_t* kg[2]; const bf16_t* vg[2]; int kd[2], vd[2];
#pragma unroll
    for (int i = 0; i < 2; ++i) { const int idx = tid + 512 * i;
        kg[i] = QK + (size_t)(tok0 + (idx >> 4)) * NQK + 1536 + h * 128 + (idx & 15) * 8; kd[i] = (idx >> 4) * DF_KROW + (idx & 15) * 16;
        vg[i] = Vt + (size_t)512 * 65536 + ((size_t)(b * 32 * 4 + h) * 128 + (idx >> 3)) * 64 + (idx & 7) * 8;        vd[i] = (idx >> 3) * DF_VROW + (idx & 7) * 16; }
    const int kfo = swap23(r32) * DF_KROW + c * 128 + hi * 16, vfo = r32 * DF_VROW + hi * 16;
    f32x16 o[4];
#pragma unroll
    for (int d0 = 0; d0 < 4; ++d0)
#pragma unroll
        for (int r = 0; r < 16; ++r) o[d0][r] = 0.f;
    float mrun = -1e30f, lsum = 0.f;
    u32x4 k0r[2], v0r[2], k1r[2], v1r[2];
#define DF_LOAD(KR, VR, T) do { _Pragma("unroll") for (int i = 0; i < 2; ++i) { KR[i] = *(const u32x4*)(kg[i] + (size_t)(T) * 64 * NQK); VR[i] = *(const u32x4*)(vg[i] + (size_t)(T) * (4 * 128 * 64)); } } while (0)
#define DF_STAGE(KR, VR, BUF) do { _Pragma("unroll") for (int i = 0; i < 2; ++i) { *(LAS u32x4*)(lds + DF_KS + (BUF) * DF_KBUF + kd[i]) = KR[i]; *(LAS u32x4*)(lds + DF_VS + (BUF) * DF_VBUF + vd[i]) = VR[i]; } } while (0)
    DF_LOAD(k0r, v0r, 0); DF_LOAD(k1r, v1r, 1);
    DF_STAGE(k0r, v0r, 0);
    if (NT > 2) DF_LOAD(k0r, v0r, 2);
    __syncthreads();
    const int kvb = 8 * hi;
    for (int t = 0; t < NT; t += 2) {
        if (t <= td) diff_tile(lds + DF_KS, lds + DF_VS, kfo, vfo, qf, o, mrun, lsum, t == td, 64 * t + kvb, qrow);
        DF_STAGE(k1r, v1r, 1);
        if (t + 3 < NT) DF_LOAD(k1r, v1r, t + 3);
        __syncthreads();
        if (t + 1 <= td) diff_tile(lds + DF_KS + DF_KBUF, lds + DF_VS + DF_VBUF, kfo, vfo, qf, o, mrun, lsum, t + 1 == td, 64 * (t + 1) + kvb, qrow);
        if (t + 2 < NT) { DF_STAGE(k0r, v0r, 0); }
        if (t + 4 < NT) DF_LOAD(k0r, v0r, t + 4);
        __syncthreads();
    }
#undef DF_LOAD
#undef DF_STAGE
    float ltot; { float lo, up; halves(lsum, lo, up); ltot = lo + up; }
    LAS float* X = (LAS float*)lds;
    if (c == 1) {
        const float f = lam / ltot;
#pragma unroll
        for (int d0 = 0; d0 < 4; ++d0)
#pragma unroll
            for (int r = 0; r < 16; ++r) X[((g * 4 + d0) * 16 + r) * 64 + lane] = o[d0][r] * f;
    }
    __syncthreads();
    if (c == 0) {
        const float inv = 1.0f / ltot; float ss = 0.f;
#pragma unroll
        for (int d0 = 0; d0 < 4; ++d0)
#pragma unroll
            for (int r = 0; r < 16; ++r) { const float val = o[d0][r] * inv - X[((g * 4 + d0) * 16 + r) * 64 + lane]; o[d0][r] = val; ss += val * val; }
        { float lo, up; halves(ss, lo, up); ss = lo + up; }
        const float rn = 0.8f / sqrtf(ss * (1.0f / 128.0f) + 1e-5f);
        LAS unsigned char* stg = lds + 65536 + g * (32 * 272);
#pragma unroll
        for (int d0 = 0; d0 < 4; ++d0)
#pragma unroll
            for (int g4 = 0; g4 < 4; ++g4) {
                const f32x4 gs = *(const f32x4*)(gsub + 32 * d0 + 8 * g4 + 4 * hi);
                u32x2 w; w.x = cvtpk(o[d0][4 * g4] * rn * gs[0], o[d0][4 * g4 + 1] * rn * gs[1]); w.y = cvtpk(o[d0][4 * g4 + 2] * rn * gs[2], o[d0][4 * g4 + 3] * rn * gs[3]);
                *(LAS u32x2*)(stg + r32 * 272 + (32 * d0 + 8 * g4 + 4 * hi) * 2) = w;
            }
        asm volatile("s_waitcnt lgkmcnt(0)" ::: "memory");
        bf16_t* Ow = MIX + (size_t)(tok0 + qb * 128 + g * 32) * DMIX + 512 + h * 128;
#pragma unroll
        for (int i = 0; i < 8; ++i) { const int row = 4 * i + (lane >> 4), ch = lane & 15;
            const u32x4 v = *(const LAS u32x4*)(stg + row * 272 + ch * 16);
            __builtin_nontemporal_store(v, (u32x4*)(Ow + (size_t)row * DMIX + ch * 8)); }
    }
    __syncthreads();
}
}

#ifndef MK_LAUNCHES
#define MK_LAUNCHES 1
#endif
constexpr int NWAVES = 8;
constexpr int BATCH = 32, SEQ = 2048, DM = 1024, MTOK = BATCH * SEQ, NQK = 2048, NV = 1024, FF = 2816, NGU = 2 * FF;
constexpr size_t MiB = 1u << 20;
constexpr size_t WS_RSTD1 = 0, WS_SS2 = 256 * 1024, WS_ROPEC = 512 * 1024, WS_ROPES = 768 * 1024;
constexpr size_t WS_WQK = 1 * MiB, WS_WV = 5 * MiB, WS_WO = 7 * MiB, WS_WGU = 9 * MiB, WS_WD = 20 * MiB;
constexpr size_t WS_BAR = 26 * MiB;
constexpr size_t WS_XB = 32 * MiB, WS_QK = 160 * MiB, WS_VT = 416 * MiB, WS_H = 160 * MiB, WS_MIX = 544 * MiB, WS_END = 672 * MiB;
static_assert(WS_WD + (size_t)DM * FF * 2 <= WS_XB && WS_H + (size_t)MTOK * FF * 2 <= WS_MIX, "ws map");
constexpr int LDS_BYTES = 131072;

typedef unsigned short bf16_t;
typedef float f32x4 __attribute__((ext_vector_type(4)));
typedef unsigned u32x4 __attribute__((ext_vector_type(4)));
typedef unsigned u32x2 __attribute__((ext_vector_type(2)));

__device__ __forceinline__ float wave_sum(float v) {
#pragma unroll
    for (int o = 1; o < 64; o <<= 1) v += __shfl_xor(v, o);
    return v;
}
__device__ __forceinline__ void p0_transpose_item(const float* __restrict__ W, int Nsrc, int K, int src_col0, int k0, const float* __restrict__ gk, bf16_t* __restrict__ WT, int dst_row0, LAS float* scr, int lane) {
    float wv[32];
#pragma unroll
    for (int i = 0; i < 32; ++i) wv[i] = W[(size_t)(k0 + 2 * i + (lane >> 5)) * Nsrc + src_col0 + (lane & 31)];
#pragma unroll
    for (int i = 0; i < 32; ++i) { const int kk = 2 * i + (lane >> 5); float v = wv[i]; if (gk) v *= gk[k0 + kk]; scr[kk * 33 + (lane & 31)] = v; }
    asm volatile("s_waitcnt lgkmcnt(0)" ::: "memory");
    const int c = lane & 7;
#pragma unroll
    for (int j = 0; j < 4; ++j) { const int n = (lane >> 3) + 8 * j; const LAS float* s = scr + (8 * c) * 33 + n;
        u32x4 o; o.x = pg8::cvt_pk_bf16(s[0 * 33], s[1 * 33]); o.y = pg8::cvt_pk_bf16(s[2 * 33], s[3 * 33]); o.z = pg8::cvt_pk_bf16(s[4 * 33], s[5 * 33]); o.w = pg8::cvt_pk_bf16(s[6 * 33], s[7 * 33]);
        *(u32x4*)(WT + (size_t)(dst_row0 + n) * K + k0 + 8 * c) = o; }
    asm volatile("s_waitcnt lgkmcnt(0)" ::: "memory");
}

__device__ __forceinline__ void grid_bar_fast(unsigned* cnt, unsigned target) {
    asm volatile("s_waitcnt vmcnt(0) lgkmcnt(0)" ::: "memory");
    __syncthreads();
    if (threadIdx.x == 0) {
        __builtin_amdgcn_fence(__ATOMIC_RELEASE, "agent");
        asm volatile("s_waitcnt vmcnt(0)" ::: "memory");
        (void)__hip_atomic_fetch_add(cnt, 1u, __ATOMIC_RELAXED, __HIP_MEMORY_SCOPE_AGENT);
        unsigned spins = 0;
        while (__hip_atomic_load(cnt, __ATOMIC_RELAXED, __HIP_MEMORY_SCOPE_AGENT) < target) { __builtin_amdgcn_s_sleep(2); if (++spins > (1u << 21)) break; }
        __builtin_amdgcn_fence(__ATOMIC_ACQUIRE, "agent");
        asm volatile("s_waitcnt vmcnt(0)" ::: "memory");
    }
    __syncthreads();
}

struct Args {
    const float* x; const float* attn_g; const float* w_in; const float* gq; const float* gk; const float* lq1; const float* lk1; const float* lq2; const float* lk2;
    const float* gsub; const float* w_o; const float* ffn_g; const float* w_gate; const float* w_up; const float* w_down;
    float* out; unsigned char* ws; int ph_lo, ph_hi;
};

__global__ void __launch_bounds__(NWAVES * 64, 2) fwd_megakernel(Args a) {
    extern __shared__ __attribute__((aligned(16))) unsigned char lds_raw[];
    LAS unsigned char* lds = (LAS unsigned char*)lds_raw;
    cg::grid_group grid = cg::this_grid();
    const int tid = threadIdx.x, lane = tid & 63, wave = __builtin_amdgcn_readfirstlane(tid >> 6);
    const int G = gridDim.x, bx = blockIdx.x;
    unsigned char* ws = a.ws;
    float* rstd1 = (float*)(ws + WS_RSTD1); float* ss2 = (float*)(ws + WS_SS2); float* ropec = (float*)(ws + WS_ROPEC); float* ropes = (float*)(ws + WS_ROPES);
    bf16_t* Wqk_t = (bf16_t*)(ws + WS_WQK); bf16_t* Wv_t = (bf16_t*)(ws + WS_WV); bf16_t* Wo_t = (bf16_t*)(ws + WS_WO); bf16_t* Wgu_t = (bf16_t*)(ws + WS_WGU); bf16_t* Wd_t = (bf16_t*)(ws + WS_WD);
    bf16_t* XB = (bf16_t*)(ws + WS_XB); bf16_t* QKb = (bf16_t*)(ws + WS_QK); bf16_t* Vt = (bf16_t*)(ws + WS_VT); bf16_t* HB = (bf16_t*)(ws + WS_H); bf16_t* MIX = (bf16_t*)(ws + WS_MIX);
    unsigned* barcnt = (unsigned*)(ws + WS_BAR);
    const int lo = a.ph_lo, hi = a.ph_hi;
#define IN(k) (lo <= (k) && (k) < hi)
#define SEAM(k) do { if (IN(k) && IN((k) + 1)) { if ((k) == 0) { asm volatile("s_waitcnt vmcnt(0) lgkmcnt(0)" ::: "memory"); grid.sync(); if (tid == 0) { __builtin_amdgcn_fence(__ATOMIC_ACQUIRE, "agent"); asm volatile("s_waitcnt vmcnt(0)" ::: "memory"); } __syncthreads(); } else grid_bar_fast(barcnt, (unsigned)(k) * (unsigned)G); } } while (0)

    if (IN(0)) {
        LAS float* scr = (LAS float*)(lds + wave * 16384);
        const int gw = bx * NWAVES + wave, NGW = G * NWAVES;
        constexpr int I_QK = 16 * (NQK / 32), I_V = 16 * (NV / 32), I_O = 16 * (DM / 32), I_GU = 16 * (NGU / 32), I_D = (FF / 64) * (DM / 32);
        constexpr int NITEMS = I_QK + I_V + I_O + I_GU + I_D;
        for (int it = gw; it < NITEMS; it += NGW) {
            int r = it;
            if (r < I_QK) { const int nb = r % (NQK / 32), kb = r / (NQK / 32); const int n0 = 32 * nb;
                const int pn = n0 >> 8, bj = (n0 >> 7) & 1, wc = (n0 >> 5) & 3; const int qc = 256 * pn + 64 * wc + 32 * bj; const int src = qc < 1024 ? qc : 1536 + (qc - 1024);
                p0_transpose_item(a.w_in, 3072, DM, src, 64 * kb, a.attn_g, Wqk_t, n0, scr, lane); continue; } r -= I_QK;
            if (r < I_V) { const int nb = r % (NV / 32), kb = r / (NV / 32); const int n0 = 32 * nb; const int src = n0 < 512 ? 1024 + n0 : 2560 + (n0 - 512);
                p0_transpose_item(a.w_in, 3072, DM, src, 64 * kb, a.attn_g, Wv_t, n0, scr, lane); continue; } r -= I_V;
            if (r < I_O) { const int nb = r % (DM / 32), kb = r / (DM / 32);
                p0_transpose_item(a.w_o, DM, DM, 32 * nb, 64 * kb, nullptr, Wo_t, 32 * nb, scr, lane); continue; } r -= I_O;
            if (r < I_GU) { const int nb = r % (NGU / 32), kb = r / (NGU / 32); const int n0 = 32 * nb; const int pn = n0 >> 8, bj = (n0 >> 7) & 1, dd = n0 & 127;
                p0_transpose_item(bj ? a.w_up : a.w_gate, FF, DM, 128 * pn + dd, 64 * kb, a.ffn_g, Wgu_t, n0, scr, lane); continue; } r -= I_GU;
            { const int nb = r % (DM / 32), kb = r / (DM / 32);
                p0_transpose_item(a.w_down, DM, FF, 32 * nb, 64 * kb, nullptr, Wd_t, 32 * nb, scr, lane); }
        }
        for (int m = gw; m < MTOK; m += NGW) {
            const f32x4* xr = (const f32x4*)(a.x + (size_t)m * DM) + lane; f32x4 v[4]; float s = 0.f;
#pragma unroll
            for (int j = 0; j < 4; ++j) { v[j] = __builtin_nontemporal_load(xr + 64 * j); s += (v[j][0] * v[j][0] + v[j][1] * v[j][1]) + (v[j][2] * v[j][2] + v[j][3] * v[j][3]); }
            s = wave_sum(s);
            u32x2* o8 = (u32x2*)(XB + (size_t)m * DM) + lane;
#pragma unroll
            for (int j = 0; j < 4; ++j) { u32x2 w; w.x = pg8::cvt_pk_bf16(v[j][0], v[j][1]); w.y = pg8::cvt_pk_bf16(v[j][2], v[j][3]); o8[64 * j] = w; }
            if (lane == 0) rstd1[m] = 1.0f / sqrtf(s * (1.0f / DM) + 1e-6f);
        }
        if (bx == 0 && tid == 0) __hip_atomic_store(barcnt, 0u, __ATOMIC_RELAXED, __HIP_MEMORY_SCOPE_AGENT);
        const int gt = bx * (NWAVES * 64) + tid, NGT = G * NWAVES * 64;
        for (int i = gt; i < MTOK; i += NGT) ss2[i] = 0.f;
        for (int i = gt; i < SEQ * 32; i += NGT) { const int pos = i >> 5, fi = i & 31;
            const float inv_freq = exp2f(-(float)fi * (13.287712379549449f / 32.0f));
            const float ang = (float)pos * inv_freq; ropec[i] = cosf(ang); ropes[i] = sinf(ang); }
    }
    SEAM(0);

    if (IN(1)) {
        { pg8::Gemm g{XB, Wqk_t, MTOK, NQK, DM}; pg8::StaticOrder S; S.init(MTOK, NQK, G, bx);
          pg8::EpiQK E{QKb, rstd1, a.gq, a.gk, ropec, ropes};
          pg8::gemm_phase<pg8::EpiQK, pg8::StaticOrder, true, true>(lds, g, S, E); }
        { pg8::Gemm g{Wv_t, XB, NV, MTOK, DM}; pg8::StaticOrder S; S.init(NV, MTOK, G, bx);
          pg8::EpiVt E{Vt, rstd1};
          pg8::gemm_phase<pg8::EpiVt, pg8::StaticOrder, true, true>(lds, g, S, E); }
    }
    SEAM(1);

    if (IN(2)) {
        for (int job = bx; job < BATCH * 8; job += G) {
            const int b = job >> 3, h = job & 7;
            att::sb_job(lds, QKb, Vt, MIX, b, h);
        }
        float lam;
        { const float p1 = a.lq1[lane] * a.lk1[lane], p2 = a.lq2[lane] * a.lk2[lane]; lam = expf(wave_sum(p1)) - expf(wave_sum(p2)) + 0.2f; }
        {
            const bool xm = (G == 256); const int xcd = bx & 7, ci = bx >> 3, cj = ci & 7;
            const int nun = xm ? 8 : (BATCH * 4 * 16 - bx + G - 1) / G;
            for (int u = 0; u < nun; ++u) {
                int bh, qb;
                if (xm) { bh = xcd * 16 + (u >> 1) * 4 + (ci >> 3); qb = (u & 1) ? 15 - cj : cj; } else { const int idx = bx + u * G; bh = idx >> 4; qb = idx & 15; }
                att::diff_unit(lds, QKb, Vt, MIX, a.gsub, lam, bh >> 2, bh & 3, qb);
            }
        }
    }
    SEAM(2);

    if (IN(3)) {
        pg8::Gemm g{MIX, Wo_t, MTOK, DM, DM}; pg8::StaticOrder S; S.init(MTOK, DM, G, bx);
        pg8::EpiWo E{a.x, XB, ss2};
        pg8::gemm_phase<pg8::EpiWo, pg8::StaticOrder, true, true>(lds, g, S, E);
    }
    SEAM(3);

    if (IN(4)) {
        pg8::Gemm g{XB, Wgu_t, MTOK, NGU, DM}; pg8::StaticOrder S; S.init(MTOK, NGU, G, bx);
        pg8::EpiGU E{HB, ss2};
        pg8::gemm_phase<pg8::EpiGU, pg8::StaticOrder, true, true>(lds, g, S, E);
    }
    SEAM(4);

    if (IN(5)) {
        pg8::Gemm g{HB, Wd_t, MTOK, DM, FF}; pg8::StaticOrder S; S.init(MTOK, DM, G, bx);
        pg8::EpiDown E{a.out, XB};
        pg8::gemm_phase<pg8::EpiDown, pg8::StaticOrder, true, true>(lds, g, S, E);
    }
#undef IN
#undef SEAM
}

extern "C" void kernel_launch(void* const* d_in, const int* in_sizes, int n_in, void* d_out, int out_size, void* d_ws, size_t ws_size, hipStream_t stream) {
    static int grid = 0;
    if (grid == 0) {
        if (n_in != 15 || in_sizes[0] != MTOK * DM || out_size != MTOK * DM || ws_size < WS_END) { fprintf(stderr, "kernel_launch: unexpected shapes/workspace (n_in %d, ws %zu)\n", n_in, ws_size); grid = -1; return; }
        int dev = 0, cus = 0, per_cu = 0;
        (void)hipGetDevice(&dev); (void)hipDeviceGetAttribute(&cus, hipDeviceAttributeMultiprocessorCount, dev);
        if (hipFuncSetAttribute((const void*)fwd_megakernel, hipFuncAttributeMaxDynamicSharedMemorySize, LDS_BYTES) != hipSuccess) { fprintf(stderr, "kernel_launch: hipFuncSetAttribute failed\n"); grid = -1; return; }
        if (hipOccupancyMaxActiveBlocksPerMultiprocessor(&per_cu, (const void*)fwd_megakernel, NWAVES * 64, LDS_BYTES) != hipSuccess || per_cu < 1) { fprintf(stderr, "kernel_launch: occupancy query gave %d\n", per_cu); per_cu = 1; }
        (void)hipGetLastError();
        grid = cus * per_cu;
    }
    if (grid < 0) return;
    Args a{};
    a.x = (const float*)d_in[0]; a.attn_g = (const float*)d_in[1]; a.w_in = (const float*)d_in[2]; a.gq = (const float*)d_in[3]; a.gk = (const float*)d_in[4];
    a.lq1 = (const float*)d_in[5]; a.lk1 = (const float*)d_in[6]; a.lq2 = (const float*)d_in[7]; a.lk2 = (const float*)d_in[8]; a.gsub = (const float*)d_in[9];
    a.w_o = (const float*)d_in[10]; a.ffn_g = (const float*)d_in[11]; a.w_gate = (const float*)d_in[12]; a.w_up = (const float*)d_in[13]; a.w_down = (const float*)d_in[14];
    a.out = (float*)d_out; a.ws = (unsigned char*)d_ws;
#if MK_LAUNCHES == 1
    a.ph_lo = 0; a.ph_hi = 6;
    void* args[] = {&a};
    hipError_t e = hipLaunchCooperativeKernel((const void*)fwd_megakernel, dim3(grid), dim3(NWAVES * 64), args, LDS_BYTES, stream);
    if (e != hipSuccess) fprintf(stderr, "cooperative launch failed: %s (grid %d)\n", hipGetErrorString(e), grid);
#else
    for (int p = 0; p < 6; ++p) { a.ph_lo = p; a.ph_hi = p + 1; hipLaunchKernelGGL(fwd_megakernel, dim3(grid), dim3(NWAVES * 64), LDS_BYTES, stream, a); }
#endif
}
```
